# Optimizing an MI355X kernel written in HIP

```python
import math
import jax, jax.numpy as jnp
from jax import lax
import numpy as np

D_MODEL = 1024
BATCH = 2
SEQ = 8192
DEPTH = 2

CHUNK = 64
N_LEFT_CHUNKS = 8
BAND = (N_LEFT_CHUNKS + 1) * CHUNK
HEAD_DIM = 64
N_HEADS_A = 8
N_HEADS_B = 8
WIDTH_A = N_HEADS_A * HEAD_DIM
WIDTH_B = N_HEADS_B * HEAD_DIM
POOL_WINDOWS = (2, 4, 8, 16)
N_POOL_GROUPS = len(POOL_WINDOWS)
POOL_GROUP_DIM = D_MODEL // 8
WIDTH_C = N_POOL_GROUPS * POOL_GROUP_DIM
N_BRANCHES = 3
MAX_REL_DIST = 2 * CHUNK
REL_TABLE = MAX_REL_DIST + CHUNK
D_FF = 2816
CONV_WIDTH = 3
Q_BLOCK = 128
EPS = 1e-6

IN_SIZES = (WIDTH_A, WIDTH_A, WIDTH_A, WIDTH_B, WIDTH_B, WIDTH_B, WIDTH_C,
            N_BRANCHES * D_MODEL)
IN_COLS = sum(IN_SIZES)
IN_SPLITS = [int(v) for v in np.cumsum(IN_SIZES)[:-1]]

kernel_name = "hybrid_chunk_causal_gated_branches"


def rms_norm(x, gain):
    xf = x.astype(jnp.float32)
    y = xf * lax.rsqrt(jnp.mean(xf * xf, axis=-1, keepdims=True) + EPS)
    return (y * gain.astype(jnp.float32)).astype(x.dtype)


def chunked_rel_attention(q, k, v, g_q, g_k, rel_bias):
    B, S, H, Dh = q.shape
    nc = S // CHUNK
    q = rms_norm(q, g_q)
    k = rms_norm(k, g_k)
    qc = q.reshape(B, nc, CHUNK, H, Dh)
    pad = ((0, 0), (N_LEFT_CHUNKS, 0), (0, 0), (0, 0), (0, 0))
    kp = jnp.pad(k.reshape(B, nc, CHUNK, H, Dh), pad)
    vp = jnp.pad(v.reshape(B, nc, CHUNK, H, Dh), pad)
    k_band = jnp.concatenate([kp[:, j:j + nc] for j in range(N_LEFT_CHUNKS + 1)], axis=2)
    v_band = jnp.concatenate([vp[:, j:j + nc] for j in range(N_LEFT_CHUNKS + 1)], axis=2)
    logits = jnp.einsum('bcqhd,bckhd->bhcqk', qc, k_band).astype(jnp.float32) / math.sqrt(Dh)
    q_off = jnp.arange(CHUNK)[:, None] + N_LEFT_CHUNKS * CHUNK
    k_off = jnp.arange(BAND)[None, :]
    rel = jnp.clip(q_off - k_off, -(CHUNK - 1), MAX_REL_DIST) + (CHUNK - 1)
    bias = rel_bias.astype(jnp.float32)[:, rel]
    valid = (jnp.arange(nc)[:, None] + k_off // CHUNK - N_LEFT_CHUNKS) >= 0
    logits = jnp.where(valid[None, None, :, None, :], logits + bias[None, :, None], -1e30)
    p = jax.nn.softmax(logits, axis=-1)
    out = jnp.einsum('bhcqk,bckhd->bcqhd', p.astype(v.dtype), v_band)
    return out.reshape(B, S, H * Dh)


def stick_breaking_attention(q, k, v):
    B, S, H, Dh = q.shape
    nb = S // Q_BLOCK
    scale = 1.0 / math.sqrt(Dh)
    qb = q.reshape(B, nb, Q_BLOCK, H, Dh).transpose(1, 0, 2, 3, 4)
    k_pos = jnp.arange(S)
    starts = jnp.arange(nb, dtype=jnp.int32) * Q_BLOCK

    def block(args):
        q_blk, start = args
        z = jnp.einsum('bqhd,bkhd->bhqk', q_blk, k).astype(jnp.float32) * scale
        q_pos = start + jnp.arange(Q_BLOCK)
        before = k_pos[None, :] < q_pos[:, None]
        log_keep = jnp.where(before, jax.nn.log_sigmoid(-z), 0.0)
        tail = lax.cumsum(log_keep, axis=3, reverse=True) - log_keep
        w = jnp.where(before, jnp.exp(jax.nn.log_sigmoid(z) + tail), 0.0)
        return jnp.einsum('bhqk,bkhd->bqhd', w.astype(v.dtype), v)

    out = lax.map(block, (qb, starts))
    return out.transpose(1, 0, 2, 3, 4).reshape(B, S, H * Dh)


def multiscale_pool(u, w_group, scale):
    B, S, _ = u.shape
    uf = u.astype(jnp.float32).reshape(B, S, N_POOL_GROUPS, POOL_GROUP_DIM)
    cs = jnp.pad(jnp.cumsum(uf, axis=1), ((0, 0), (1, 0), (0, 0), (0, 0)))
    t = jnp.arange(S)
    pooled = []
    for g, win in enumerate(POOL_WINDOWS):
        lo = jnp.maximum(t + 1 - win, 0)
        win_sum = cs[:, 1:, g] - cs[:, lo, g]
        count = (t + 1 - lo).astype(jnp.float32)
        pooled.append(win_sum / count[None, :, None])
    pooled = jnp.stack(pooled, axis=2) - uf
    mixed = jnp.einsum('bsgc,gce->bsge', pooled.astype(u.dtype), w_group)
    return mixed.reshape(B, S, WIDTH_C) * scale


def conv_gated_mlp(h, w_up, conv_w, conv_b, w_down):
    S = h.shape[1]
    u = h @ w_up
    up = jnp.pad(u, ((0, 0), (CONV_WIDTH - 1, 0), (0, 0)))
    c = conv_b + conv_w[0] * up[:, 0:S]
    for j in range(1, CONV_WIDTH):
        c = c + conv_w[j] * up[:, j:j + S]
    gate, val = jnp.split(c, 2, axis=-1)
    return (jax.nn.silu(gate) * val) @ w_down


def setup_inputs(seed: int = 0) -> dict:
    key = jax.random.key(seed)
    ks = jax.random.split(key, 20)
    f32 = jnp.float32
    n = lambda k, shape, s: jax.random.normal(k, shape, f32) * s
    L = DEPTH
    return {
        "x": n(ks[0], (BATCH, SEQ, D_MODEL), 1.0),
        "norm_mix": 1.0 + n(ks[1], (L, D_MODEL), 0.05),
        "w_in": n(ks[2], (L, D_MODEL, IN_COLS), D_MODEL ** -0.5),
        "b_gate": n(ks[3], (L, N_BRANCHES * D_MODEL), 0.1),
        "q_norm_a": 1.0 + n(ks[4], (L, HEAD_DIM), 0.05),
        "k_norm_a": 1.0 + n(ks[5], (L, HEAD_DIM), 0.05),
        "rel_bias_a": n(ks[6], (L, N_HEADS_A, REL_TABLE), 0.5),
        "w_pool": n(ks[7], (L, N_POOL_GROUPS, POOL_GROUP_DIM, POOL_GROUP_DIM), POOL_GROUP_DIM ** -0.5),
        "pool_scale": 1.0 + n(ks[8], (L, WIDTH_C), 0.1),
        "w_branch_a": n(ks[9], (L, WIDTH_A, D_MODEL), WIDTH_A ** -0.5),
        "w_branch_b": n(ks[10], (L, WIDTH_B, D_MODEL), WIDTH_B ** -0.5),
        "w_branch_c": n(ks[11], (L, WIDTH_C, D_MODEL), WIDTH_C ** -0.5),
        "w_out": n(ks[12], (L, D_MODEL, D_MODEL), D_MODEL ** -0.5),
        "norm_ffn": 1.0 + n(ks[13], (L, D_MODEL), 0.05),
        "w_up": n(ks[14], (L, D_MODEL, 2 * D_FF), D_MODEL ** -0.5),
        "conv_w": n(ks[15], (L, CONV_WIDTH, 2 * D_FF), CONV_WIDTH ** -0.5),
        "conv_b": n(ks[16], (L, 2 * D_FF), 0.02),
        "w_down": n(ks[17], (L, D_FF, D_MODEL), D_FF ** -0.5),
    }


def reference(x, norm_mix, w_in, b_gate, q_norm_a, k_norm_a, rel_bias_a, w_pool,
              pool_scale, w_branch_a, w_branch_b, w_branch_c, w_out, norm_ffn,
              w_up, conv_w, conv_b, w_down):
    B, S, D = x.shape
    for l in range(DEPTH):
        h = rms_norm(x, norm_mix[l])
        proj = h @ w_in[l]
        q_a, k_a, v_a, q_b, k_b, v_b, u_c, g_logits = jnp.split(proj, IN_SPLITS, axis=-1)
        heads_a = lambda t: t.reshape(B, S, N_HEADS_A, HEAD_DIM)
        heads_b = lambda t: t.reshape(B, S, N_HEADS_B, HEAD_DIM)
        o_a = chunked_rel_attention(heads_a(q_a), heads_a(k_a), heads_a(v_a),
                                    q_norm_a[l], k_norm_a[l], rel_bias_a[l])
        o_b = stick_breaking_attention(heads_b(q_b), heads_b(k_b), heads_b(v_b))
        o_c = multiscale_pool(u_c, w_pool[l], pool_scale[l])
        gates = jax.nn.sigmoid((g_logits + b_gate[l]).astype(jnp.float32)).astype(x.dtype)
        gates = gates.reshape(B, S, N_BRANCHES, D)
        merged = (gates[:, :, 0] * (o_a @ w_branch_a[l])
                  + gates[:, :, 1] * (o_b @ w_branch_b[l])
                  + gates[:, :, 2] * (o_c @ w_branch_c[l]))
        x = x + merged @ w_out[l]
        h2 = rms_norm(x, norm_ffn[l])
        x = x + conv_gated_mlp(h2, w_up[l], conv_w[l], conv_b[l], w_down[l])
    return x
```

```cpp
#include <hip/hip_runtime.h>
#include <hip/hip_cooperative_groups.h>
#include <cstdio>
#include <cstdint>
namespace cg = cooperative_groups;

#define LAS __attribute__((address_space(3)))
typedef unsigned short bf16_t;
typedef short bf16x8 __attribute__((ext_vector_type(8)));
typedef float f32x4 __attribute__((ext_vector_type(4)));
typedef unsigned u32x4 __attribute__((ext_vector_type(4)));
typedef unsigned u32x2 __attribute__((ext_vector_type(2)));
typedef float f32x2_t __attribute__((ext_vector_type(2)));
typedef __bf16 bf16x2_t __attribute__((ext_vector_type(2)));

#ifndef EARLY_EXIT
#define EARLY_EXIT 1
#endif
#define REP_A 1
#define REP_B 1
#define REP_G1 1
#define REP_G4 1
#define REP_SYNC 1
#define REP_MISC 1
#define REP_G235 1
#define GRID_SYNC() do { for (int r_ = 0; r_ < REP_SYNC; ++r_) xcd_barrier(xbar); } while (0)

constexpr int T = 16384, SEQ = 8192, DM = 1024, NIN = 6656, DFF = 2816, NUP = 5632, NL = 2;
constexpr float EPS = 1e-6f;
constexpr size_t MiB = 1u << 20;
constexpr size_t WS_STAT = 1 * MiB;
constexpr size_t WS_WIN = 2 * MiB;
constexpr size_t WS_XB = 15 * MiB;
constexpr size_t WS_OC = 15 * MiB;
constexpr size_t WS_WA = 31 * MiB, WS_WB = 32 * MiB, WS_WC = 33 * MiB, WS_WOUT = 34 * MiB;
constexpr size_t WS_WUP = 36 * MiB;
constexpr size_t WS_UC = 47 * MiB, WS_KA = 63 * MiB, WS_VA = 79 * MiB, WS_KB = 95 * MiB, WS_VB = 111 * MiB, WS_QA = 127 * MiB, WS_QB = 143 * MiB;
constexpr size_t WS_GATES = 159 * MiB;
constexpr size_t WS_WDN = 47 * MiB;
constexpr size_t WS_MERGED = 63 * MiB;
constexpr size_t WS_X1B = 95 * MiB;
constexpr size_t WS_ACT = 127 * MiB;
constexpr size_t WS_EDGE = 215 * MiB;
constexpr int LDS_BYTES = 143360;
constexpr int XB_LDS_OFF = 141312;
constexpr size_t WS_BAR = 16384, WS_CTL_BYTES = 65536;

__device__ __forceinline__ unsigned cvtpk(float lo, float hi) { f32x2_t v = {lo, hi}; bf16x2_t b = __builtin_convertvector(v, bf16x2_t); return __builtin_bit_cast(unsigned, b); }
__device__ __forceinline__ float bf_lo(unsigned w) { return __uint_as_float(w << 16); }
__device__ __forceinline__ float bf_hi(unsigned w) { return __uint_as_float(w & 0xffff0000u); }
__device__ __forceinline__ float rs_of(const float* stat, int row) {
    const f32x4* p = (const f32x4*)(stat + (size_t)row * 16); const f32x4 a = p[0], b = p[1], c = p[2], d = p[3];
    const float s = ((a.x + a.y) + (a.z + a.w)) + ((b.x + b.y) + (b.z + b.w)) + ((c.x + c.y) + (c.z + c.w)) + ((d.x + d.y) + (d.z + d.w));
    return rsqrtf(s * (1.0f / 1024.0f) + EPS);
}
__device__ __forceinline__ size_t plane_off(int blk) {
    return blk == 0 ? WS_QA : blk == 1 ? WS_KA : blk == 2 ? WS_VA : blk == 3 ? WS_QB : blk == 4 ? WS_KB : blk == 5 ? WS_VB : WS_UC;
}

namespace pg8 {
constexpr int BM = 256, BK = 64, HALF = 128, HTB = HALF * BK * 2, STAGE_BYTES = 8 * HTB, NXCD = 8, WGM = 8;
__host__ __device__ __forceinline__ int lds_byte(int r, int c) { const int st = (r >> 4) * 2 + (c >> 5), rr = r & 15, cc = c & 31, ob = rr * 64 + cc * 2; return st * 1024 + (ob ^ (((ob >> 9) & 1) << 5)); }
__host__ __device__ __forceinline__ void stage_rc(int b, int& R, int& C) { const int st = b / 1024, sb = b % 1024, swz = sb ^ (((sb >> 9) & 1) << 5); R = (st >> 1) * 16 + swz / 64; C = (st & 1) * 32 + (swz % 64) / 2; }
__host__ __device__ __forceinline__ int perm32(int rho) { const int n = rho >> 4, i = rho & 15; return 8 * (i >> 2) + 4 * n + (i & 3); }

struct Unit { int pm, pn, br, hf; };
struct Gemm { const bf16_t *A0, *A1, *A2; const bf16_t *B0, *B1, *B2; int lda, ldb, K; };
template <int M_, int N_, int NB, int HALVES> struct Order {
    static constexpr int nM = M_ / BM, nN = N_ / BM, nwg = nM * nN;
    int G, c;
    __device__ __forceinline__ void init(int G_, int c_) { G = G_; c = c_; }
    __device__ __forceinline__ int nfull() const { return nwg / G; }
    __device__ __forceinline__ bool halft() const { const int nf = nwg / G; return HALVES && NB == 1 && nf >= 1 && (nwg - nf * G) * 2 == G; }
    __device__ __forceinline__ bool next(int i, Unit& u) const {
        const int rnd = i / NB; u.br = i - rnd * NB; u.hf = -1;
        int L = rnd * G + c;
        if (HALVES && NB == 1) { const int nf = nwg / G; if ((nwg - nf * G) * 2 == G && nf >= 1) {
            if ((c >> 3) & 1) { if (i == 0) { L = nf * G + (c >> 1); u.hf = c & 1; } else { if (i > nf) return false; L = (i - 1) * G + c; } }
            else if (rnd >= nf) { if (rnd > nf) return false; L = nf * G + (c >> 1); u.hf = c & 1; } } }
        if (L >= nwg) return false;
        int wgid = L; { constexpr int q = nwg / NXCD, r = nwg % NXCD; const int xcd = wgid % NXCD, off = wgid / NXCD; wgid = (xcd < r ? xcd * (q + 1) : r * (q + 1) + (xcd - r) * q) + off; }
        constexpr int nig = WGM * nN; const int gid = wgid / nig, fm = gid * WGM, gsz = (nM - fm) < WGM ? (nM - fm) : WGM;
        u.pm = fm + ((wgid % nig) % gsz); u.pn = (wgid % nig) / gsz; return true;
    }
};

template <class Epi, class Sched>
__device__ __forceinline__ void gemm_phase(LAS unsigned char* lds, const Gemm g, const Sched& S, const Epi& E) {
    int tid = threadIdx.x; asm volatile("" : "+v"(tid));
    const int wid = __builtin_amdgcn_readfirstlane(tid >> 6), lane = tid & 63, wr = wid >> 2, wc = wid & 3, fr = lane & 15, fq = lane >> 4;
    const int nt = g.K / BK;
    unsigned voffA[2], voffB[2];
#pragma unroll
    for (int i = 0; i < 2; ++i) { int R, C; stage_rc(tid * 16 + i * 8192, R, C); const int Rb = (R & ~31) + perm32(R & 31);
        voffA[i] = (unsigned)(R * g.lda + C) * 2u; voffB[i] = (unsigned)(Rb * g.ldb + C) * 2u; }
    const size_t kstep = (size_t)(BK * 2);
    const size_t hstepA = (size_t)HALF * g.lda * 2, tstepA = 2 * hstepA, hstepB = (size_t)HALF * g.ldb * 2, tstepB = 2 * hstepB;
    const unsigned ldsw = (unsigned)wid * 1024u;
    const int aoff = lds_byte(wr * 64 + fr, fq * 8), boff = lds_byte(wc * 32 + fr, fq * 8);
#define PG8_SA(b, h) (((b) * 2 + (h)) * HTB)
#define PG8_SB(b, h) ((4 + (b) * 2 + (h)) * HTB)
#define PG8_STAGE(bufoff, gbase, voff) do { _Pragma("unroll") for (int _i = 0; _i < 2; ++_i) \
        __builtin_amdgcn_global_load_lds((const unsigned*)((const char*)(gbase) + (voff)[_i]), (LAS unsigned*)(lds + (bufoff) + ldsw + _i * 8192), 16, 0, 0); } while (0)
#define PG8_LDA(dst, b, h) do { _Pragma("unroll") for (int m = 0; m < 4; ++m) _Pragma("unroll") for (int k = 0; k < 2; ++k) dst[m][k] = *(const LAS bf16x8*)(lds + PG8_SA(b, h) + aoff + m * 2048 + k * 1024); } while (0)
#define PG8_LDB(dst, b, h) do { _Pragma("unroll") for (int n = 0; n < 2; ++n) _Pragma("unroll") for (int k = 0; k < 2; ++k) dst[n][k] = *(const LAS bf16x8*)(lds + PG8_SB(b, h) + boff + n * 2048 + k * 1024); } while (0)
#define PG8_MMA(ai, bj, At, Bt) do { __builtin_amdgcn_s_setprio(1); _Pragma("unroll") for (int m = 0; m < 4; ++m) _Pragma("unroll") for (int n = 0; n < 2; ++n) _Pragma("unroll") for (int k = 0; k < 2; ++k) \
        acc[ai][bj][m][n] = __builtin_amdgcn_mfma_f32_16x16x32_bf16(Bt[n][k], At[m][k], acc[ai][bj][m][n], 0, 0, 0); __builtin_amdgcn_s_setprio(0); } while (0)
#define PG8_WAIT_V(n) asm volatile("s_waitcnt vmcnt(" #n ")" ::: "memory")
#define PG8_WAIT_L(n) asm volatile("s_waitcnt lgkmcnt(" #n ")" ::: "memory")
#define PG8_BAR __builtin_amdgcn_s_barrier()
#define PG8_SCHED __builtin_amdgcn_sched_barrier(0)
#define PG8_ABASE(u) ((const char*)((u).br == 0 ? g.A0 : ((u).br == 1 ? g.A1 : g.A2)) + (size_t)(u).pm * tstepA)
#define PG8_BBASE(u) ((const char*)((u).br == 0 ? g.B0 : ((u).br == 1 ? g.B1 : g.B2)) + (size_t)(u).pn * tstepB + ((u).hf > 0 ? hstepB : (size_t)0))
    Unit cur, nxt; int ui = 0;
    if (!S.next(0, cur)) return;
    if constexpr (Epi::NEED_RS) {
        LAS float* rst = (LAS float*)(lds + STAGE_BYTES);
        Unit uu;
        for (int i = tid >> 8; S.next(i, uu); i += 2) rst[i * 256 + (tid & 255)] = rs_of(E.stat, uu.pm * 256 + (tid & 255));
        __syncthreads();
    }
    f32x4 acc[2][2][4][2];
#pragma unroll
    for (int a = 0; a < 2; ++a)
#pragma unroll
        for (int b = 0; b < 2; ++b)
#pragma unroll
            for (int m = 0; m < 4; ++m)
#pragma unroll
                for (int n = 0; n < 2; ++n) acc[a][b][m][n] = (f32x4){0.f, 0.f, 0.f, 0.f};
    bf16x8 At[4][2], B0[2][2], B1[2][2];
    const char* cA = PG8_ABASE(cur); const char* cB = PG8_BBASE(cur);
    if (cur.hf >= 0) {
    PG8_STAGE(PG8_SB(0, 0), cB, voffB); PG8_STAGE(PG8_SA(0, 0), cA, voffA); PG8_STAGE(PG8_SA(0, 1), cA + hstepA, voffA);
    if (wr == 1) PG8_BAR;
    PG8_WAIT_V(2); PG8_BAR;
    PG8_STAGE(PG8_SB(1, 0), cB + kstep, voffB); PG8_STAGE(PG8_SA(1, 0), cA + kstep, voffA);
    PG8_WAIT_V(4); PG8_BAR;
    } else {
    PG8_STAGE(PG8_SB(0, 0), cB, voffB); PG8_STAGE(PG8_SB(0, 1), cB + hstepB, voffB); PG8_STAGE(PG8_SA(0, 0), cA, voffA); PG8_STAGE(PG8_SA(0, 1), cA + hstepA, voffA);
    if (wr == 1) PG8_BAR;
    PG8_WAIT_V(2); PG8_BAR;
    PG8_STAGE(PG8_SB(1, 0), cB + kstep, voffB); PG8_STAGE(PG8_SA(1, 0), cA + kstep, voffA); PG8_STAGE(PG8_SB(1, 1), cB + hstepB + kstep, voffB);
    PG8_WAIT_V(6); PG8_BAR;
    }
    for (;;) {
        const bool has_next = S.next(ui + 1, nxt);
        const char* nA = has_next ? PG8_ABASE(nxt) : cA; const char* nB = has_next ? PG8_BBASE(nxt) : cB;
        if (cur.hf >= 0) {
        const int nth = has_next ? nt - 2 : nt;
        for (int t = 0; t < nth; t += 2) {
            const bool last = (t == nt - 2);
            const char* a1 = cA + (size_t)(t + 1) * kstep;
            const char* a2 = last ? nA : cA + (size_t)(t + 2) * kstep; const char* b2 = last ? nB : cB + (size_t)(t + 2) * kstep;
            const char* a3 = a2 + kstep; const char* b3 = b2 + kstep;
            PG8_LDB(B0, 0, 0); PG8_SCHED; PG8_LDA(At, 0, 0); PG8_STAGE(PG8_SA(1, 1), a1 + hstepA, voffA);
            PG8_WAIT_V(6); PG8_WAIT_L(0); PG8_BAR; PG8_MMA(0, 0, At, B0); PG8_BAR; PG8_SCHED;
            PG8_LDA(At, 0, 1); PG8_STAGE(PG8_SB(0, 0), b2, voffB); PG8_STAGE(PG8_SA(0, 0), a2, voffA);
            PG8_WAIT_V(6); PG8_WAIT_L(0); PG8_BAR; PG8_MMA(1, 0, At, B0); PG8_BAR; PG8_SCHED;
            PG8_LDB(B0, 1, 0); PG8_SCHED; PG8_LDA(At, 1, 0); PG8_STAGE(PG8_SA(0, 1), a2 + hstepA, voffA);
            PG8_WAIT_V(6); PG8_WAIT_L(0); PG8_BAR; PG8_MMA(0, 0, At, B0); PG8_BAR; PG8_SCHED;
            PG8_LDA(At, 1, 1); PG8_STAGE(PG8_SB(1, 0), b3, voffB); PG8_STAGE(PG8_SA(1, 0), a3, voffA);
            PG8_WAIT_V(6); PG8_WAIT_L(0); PG8_BAR; PG8_MMA(1, 0, At, B0); PG8_BAR; PG8_SCHED;
        }
        if (has_next) {
            const char* a1 = cA + (size_t)(nt - 1) * kstep;
            const char* a2 = nA; const char* b2 = nB; const char* a3 = a2 + kstep; const char* b3 = b2 + kstep;
            PG8_LDB(B0, 0, 0); PG8_SCHED; PG8_LDA(At, 0, 0); PG8_STAGE(PG8_SA(1, 1), a1 + hstepA, voffA);
            PG8_WAIT_V(6); PG8_WAIT_L(0); PG8_BAR; PG8_MMA(0, 0, At, B0); PG8_BAR; PG8_SCHED;
            PG8_LDA(At, 0, 1); PG8_STAGE(PG8_SB(0, 0), b2, voffB); PG8_STAGE(PG8_SB(0, 1), b2 + hstepB, voffB); PG8_STAGE(PG8_SA(0, 0), a2, voffA);
            PG8_WAIT_V(8); PG8_WAIT_L(0); PG8_BAR; PG8_MMA(1, 0, At, B0); PG8_BAR; PG8_SCHED;
            PG8_LDB(B0, 1, 0); PG8_SCHED; PG8_LDA(At, 1, 0); PG8_STAGE(PG8_SA(0, 1), a2 + hstepA, voffA);
            PG8_WAIT_V(8); PG8_WAIT_L(0); PG8_BAR; PG8_MMA(0, 0, At, B0); PG8_BAR; PG8_SCHED;
            PG8_LDA(At, 1, 1); PG8_STAGE(PG8_SB(1, 0), b3, voffB); PG8_STAGE(PG8_SB(1, 1), b3 + hstepB, voffB); PG8_STAGE(PG8_SA(1, 0), a3, voffA);
            PG8_WAIT_V(8); PG8_WAIT_L(0); PG8_BAR; PG8_MMA(1, 0, At, B0); PG8_BAR; PG8_SCHED;
        }
        } else
        for (int t = 0; t < nt; t += 2) {
            const bool last = (t == nt - 2);
            const char* a1 = cA + (size_t)(t + 1) * kstep;
            const char* a2 = last ? nA : cA + (size_t)(t + 2) * kstep; const char* b2 = last ? nB : cB + (size_t)(t + 2) * kstep;
            const char* a3 = a2 + kstep; const char* b3 = b2 + kstep;
            PG8_LDB(B0, 0, 0); PG8_LDB(B1, 0, 1); PG8_SCHED; PG8_LDA(At, 0, 0); PG8_STAGE(PG8_SA(1, 1), a1 + hstepA, voffA);
            PG8_WAIT_V(8); PG8_WAIT_L(0); PG8_BAR; PG8_MMA(0, 0, At, B0); PG8_MMA(0, 1, At, B1); PG8_BAR; PG8_SCHED;
            PG8_LDA(At, 0, 1); PG8_STAGE(PG8_SB(0, 0), b2, voffB); PG8_STAGE(PG8_SB(0, 1), b2 + hstepB, voffB); PG8_STAGE(PG8_SA(0, 0), a2, voffA);
            PG8_WAIT_V(8); PG8_WAIT_L(0); PG8_BAR; PG8_MMA(1, 0, At, B0); PG8_MMA(1, 1, At, B1); PG8_BAR; PG8_SCHED;
            PG8_LDB(B0, 1, 0); PG8_LDB(B1, 1, 1); PG8_SCHED; PG8_LDA(At, 1, 0); PG8_STAGE(PG8_SA(0, 1), a2 + hstepA, voffA);
            PG8_WAIT_V(8); PG8_WAIT_L(0); PG8_BAR; PG8_MMA(0, 0, At, B0); PG8_MMA(0, 1, At, B1); PG8_BAR; PG8_SCHED;
            PG8_LDA(At, 1, 1); PG8_STAGE(PG8_SB(1, 0), b3, voffB); PG8_STAGE(PG8_SB(1, 1), b3 + hstepB, voffB); PG8_STAGE(PG8_SA(1, 0), a3, voffA);
            PG8_WAIT_V(8); PG8_WAIT_L(0); PG8_BAR; PG8_MMA(1, 0, At, B0); PG8_MMA(1, 1, At, B1); PG8_BAR; PG8_SCHED;
        }
        if (wr == 0) PG8_BAR;
        E(acc, cur, wr, wc, fr, fq, (const LAS float*)(lds + STAGE_BYTES) + ui * 256);
        if (!has_next) break;
        if (E.zero_after(cur)) {
#pragma unroll
            for (int a = 0; a < 2; ++a)
#pragma unroll
                for (int b = 0; b < 2; ++b)
#pragma unroll
                    for (int m = 0; m < 4; ++m)
#pragma unroll
                        for (int n = 0; n < 2; ++n) acc[a][b][m][n] = (f32x4){0.f, 0.f, 0.f, 0.f};
        }
        cur = nxt; cA = nA; cB = nB; ++ui;
        if (wr == 1) PG8_BAR;
    }
    PG8_WAIT_V(0);
    PG8_BAR;
#undef PG8_SA
#undef PG8_SB
#undef PG8_STAGE
#undef PG8_LDA
#undef PG8_LDB
#undef PG8_MMA
#undef PG8_WAIT_V
#undef PG8_WAIT_L
#undef PG8_BAR
#undef PG8_SCHED
#undef PG8_ABASE
#undef PG8_BBASE
}
}

typedef f32x4 (&AccRef)[2][2][4][2];
__device__ __forceinline__ float sigmoidf_(float x) { return __builtin_amdgcn_rcpf(1.0f + __expf(-x)); }

struct EpiProj {
    static constexpr bool NEED_RS = true;
    unsigned char* ws; const float* stat; const float* bgate;
    __device__ __forceinline__ bool zero_after(const pg8::Unit&) const { return true; }
    __device__ __forceinline__ void operator()(AccRef acc, const pg8::Unit& u, int wr, int wc, int fr, int fq, const LAS float* rst) const {
        const int row0 = u.pm * 256 + wr * 64 + fr;
        const int nbj = (u.hf >= 0) ? 1 : 2, hofs = (u.hf > 0) ? 128 : 0;
        if (u.pn < 14) {
            bf16_t* base = (bf16_t*)(ws + plane_off(u.pn >> 1)); const int col0 = (u.pn & 1) * 256 + hofs + wc * 32 + 8 * fq;
#pragma unroll
            for (int ai = 0; ai < 2; ++ai)
#pragma unroll
                for (int m = 0; m < 4; ++m) { const int row = row0 + ai * 128 + m * 16; const float rs = rst[wr * 64 + fr + ai * 128 + m * 16]; bf16_t* rowp = base + (size_t)row * 512 + col0;
#pragma unroll
                    for (int bj = 0; bj < 2; ++bj) if (bj < nbj) { const f32x4 v0 = acc[ai][bj][m][0] * rs, v1 = acc[ai][bj][m][1] * rs;
                        u32x4 w; w.x = cvtpk(v0[0], v0[1]); w.y = cvtpk(v0[2], v0[3]); w.z = cvtpk(v1[0], v1[1]); w.w = cvtpk(v1[2], v1[3]);
                        *(u32x4*)(rowp + bj * 128) = w; } }
        } else {
            bf16_t* base = (bf16_t*)(ws + WS_GATES); const int col0 = (u.pn - 14) * 256 + hofs + wc * 32 + 8 * fq;
            f32x4 bv[2][2];
#pragma unroll
            for (int bj = 0; bj < 2; ++bj)
#pragma unroll
                for (int n = 0; n < 2; ++n) bv[bj][n] = *(const f32x4*)(bgate + col0 + bj * 128 + 4 * n);
#pragma unroll
            for (int ai = 0; ai < 2; ++ai)
#pragma unroll
                for (int m = 0; m < 4; ++m) { const int row = row0 + ai * 128 + m * 16; const float rs = rst[wr * 64 + fr + ai * 128 + m * 16]; bf16_t* rowp = base + (size_t)row * 3072 + col0;
#pragma unroll
                    for (int bj = 0; bj < 2; ++bj) if (bj < nbj) { f32x4 v0 = acc[ai][bj][m][0] * rs + bv[bj][0], v1 = acc[ai][bj][m][1] * rs + bv[bj][1];
#pragma unroll
                        for (int e = 0; e < 4; ++e) { v0[e] = fmaxf(sigmoidf_(v0[e]), 8.7e-19f); v1[e] = fmaxf(sigmoidf_(v1[e]), 8.7e-19f); }
                        u32x4 w; w.x = cvtpk(v0[0], v0[1]); w.y = cvtpk(v0[2], v0[3]); w.z = cvtpk(v1[0], v1[1]); w.w = cvtpk(v1[2], v1[3]);
                        *(u32x4*)(rowp + bj * 128) = w; } }
        }
    }
};

struct EpiBranch {
    static constexpr bool NEED_RS = false;
    const bf16_t* gates; bf16_t* merged;
    __device__ __forceinline__ bool zero_after(const pg8::Unit& u) const { return u.br == 2; }
    __device__ __forceinline__ void operator()(AccRef acc, const pg8::Unit& u, int wr, int wc, int fr, int fq, const LAS float* rst) const {
        const int row0 = u.pm * 256 + wr * 64 + fr, col0 = u.pn * 256 + wc * 32 + 8 * fq;
#define RCP_(x) __builtin_amdgcn_rcpf(x)
#pragma unroll
        for (int ai = 0; ai < 2; ++ai) {
            if (u.br < 2) {
                u32x4 ga[4][2], gb[4][2];
#pragma unroll
                for (int m = 0; m < 4; ++m)
#pragma unroll
                    for (int bj = 0; bj < 2; ++bj) { const bf16_t* gp = gates + (size_t)(row0 + ai * 128 + m * 16) * 3072 + col0 + bj * 128;
                        ga[m][bj] = *(const u32x4*)(gp + u.br * 1024); gb[m][bj] = *(const u32x4*)(gp + (u.br + 1) * 1024); }
#pragma unroll
                for (int m = 0; m < 4; ++m)
#pragma unroll
                    for (int bj = 0; bj < 2; ++bj) { const u32x4 a = ga[m][bj], b = gb[m][bj];
                        f32x4 r0, r1;
                        r0[0] = bf_lo(a.x) * RCP_(bf_lo(b.x)); r0[1] = bf_hi(a.x) * RCP_(bf_hi(b.x)); r0[2] = bf_lo(a.y) * RCP_(bf_lo(b.y)); r0[3] = bf_hi(a.y) * RCP_(bf_hi(b.y));
                        r1[0] = bf_lo(a.z) * RCP_(bf_lo(b.z)); r1[1] = bf_hi(a.z) * RCP_(bf_hi(b.z)); r1[2] = bf_lo(a.w) * RCP_(bf_lo(b.w)); r1[3] = bf_hi(a.w) * RCP_(bf_hi(b.w));
                        acc[ai][bj][m][0] *= r0; acc[ai][bj][m][1] *= r1; }
            } else {
                u32x4 gc[4][2];
#pragma unroll
                for (int m = 0; m < 4; ++m)
#pragma unroll
                    for (int bj = 0; bj < 2; ++bj) gc[m][bj] = *(const u32x4*)(gates + (size_t)(row0 + ai * 128 + m * 16) * 3072 + col0 + bj * 128 + 2048);
#pragma unroll
                for (int m = 0; m < 4; ++m)
#pragma unroll
                    for (int bj = 0; bj < 2; ++bj) { const u32x4 a = gc[m][bj]; const int row = row0 + ai * 128 + m * 16;
                        f32x4 g0, g1; g0[0] = bf_lo(a.x); g0[1] = bf_hi(a.x); g0[2] = bf_lo(a.y); g0[3] = bf_hi(a.y); g1[0] = bf_lo(a.z); g1[1] = bf_hi(a.z); g1[2] = bf_lo(a.w); g1[3] = bf_hi(a.w);
                        const f32x4 v0 = acc[ai][bj][m][0] * g0, v1 = acc[ai][bj][m][1] * g1;
                        u32x4 w; w.x = cvtpk(v0[0], v0[1]); w.y = cvtpk(v0[2], v0[3]); w.z = cvtpk(v1[0], v1[1]); w.w = cvtpk(v1[2], v1[3]);
                        *(u32x4*)(merged + (size_t)row * 1024 + col0 + bj * 128) = w; }
            }
        }
#undef RCP_
    }
};

struct EpiResid {
    static constexpr bool NEED_RS = false;
    const float* base; float* out; bf16_t* xb; float* stat; int extras; int store;
    const bf16_t* base16; int f32out;
    __device__ __forceinline__ bool zero_after(const pg8::Unit&) const { return true; }
    __device__ __forceinline__ void operator()(AccRef acc, const pg8::Unit& u, int wr, int wc, int fr, int fq, const LAS float* rst) const {
        const int row0 = u.pm * 256 + wr * 64 + fr, col0 = u.pn * 256 + wc * 32 + 8 * fq;
#pragma unroll
        for (int ai = 0; ai < 2; ++ai) {
            f32x4 B0[4][2], B1[4][2];
            if (base16) {
                u32x4 bw[4][2];
#pragma unroll
                for (int m = 0; m < 4; ++m)
#pragma unroll
                    for (int bj = 0; bj < 2; ++bj) bw[m][bj] = *(const u32x4*)(base16 + (size_t)(row0 + ai * 128 + m * 16) * 1024 + col0 + bj * 128);
#pragma unroll
                for (int m = 0; m < 4; ++m)
#pragma unroll
                    for (int bj = 0; bj < 2; ++bj) { const u32x4 w_ = bw[m][bj]; B0[m][bj] = (f32x4){bf_lo(w_.x), bf_hi(w_.x), bf_lo(w_.y), bf_hi(w_.y)}; B1[m][bj] = (f32x4){bf_lo(w_.z), bf_hi(w_.z), bf_lo(w_.w), bf_hi(w_.w)}; }
            } else {
#pragma unroll
                for (int m = 0; m < 4; ++m)
#pragma unroll
                    for (int bj = 0; bj < 2; ++bj) { const size_t off = (size_t)(row0 + ai * 128 + m * 16) * 1024 + col0 + bj * 128; B0[m][bj] = *(const f32x4*)(base + off); B1[m][bj] = *(const f32x4*)(base + off + 4); }
            }
#pragma unroll
            for (int m = 0; m < 4; ++m) { const int row = row0 + ai * 128 + m * 16; float ss = 0.f;
#pragma unroll
                for (int bj = 0; bj < 2; ++bj) { const size_t off = (size_t)row * 1024 + col0 + bj * 128;
                    const f32x4 o0 = B0[m][bj] + acc[ai][bj][m][0], o1 = B1[m][bj] + acc[ai][bj][m][1];
                    if (store && f32out) { *(f32x4*)(out + off) = o0; *(f32x4*)(out + off + 4) = o1; }
                    if (extras && store) { u32x4 w; w.x = cvtpk(o0[0], o0[1]); w.y = cvtpk(o0[2], o0[3]); w.z = cvtpk(o1[0], o1[1]); w.w = cvtpk(o1[2], o1[3]); *(u32x4*)(xb + off) = w; }
                    ss += (o0[0] * o0[0] + o0[1] * o0[1]) + (o0[2] * o0[2] + o0[3] * o0[3]) + (o1[0] * o1[0] + o1[1] * o1[1]) + (o1[2] * o1[2] + o1[3] * o1[3]); }
                ss += __shfl_xor(ss, 16); ss += __shfl_xor(ss, 32);
                if (extras && store && fq == 0) stat[(size_t)row * 16 + u.pn * 4 + wc] = ss; }
        }
    }
};

template <int N> __device__ __forceinline__ float dpp_ror(float v) {
    return __builtin_bit_cast(float, __builtin_amdgcn_update_dpp(0, __builtin_bit_cast(int, v), 0x120 + N, 0xF, 0xF, false));
}
struct EpiUp {
    static constexpr bool NEED_RS = true;
    const float* stat; const float* convw; const float* convb; bf16_t* act; float* edge;
    __device__ __forceinline__ bool zero_after(const pg8::Unit&) const { return true; }
    __device__ __forceinline__ void operator()(AccRef acc, const pg8::Unit& u, int wr, int wc, int fr, int fq, const LAS float* rst) const {
        const int row0 = u.pm * 256 + wr * 64 + fr;
        const int nbj = (u.hf >= 0) ? 1 : 2, hb = (u.hf > 0) ? 1 : 0;
#pragma unroll
        for (int bj = 0; bj < 2; ++bj) if (bj < nbj) {
            const int j = u.pn * 128 + (bj + hb) * 64 + wc * 16 + 4 * fq;
            const f32x4 g0 = *(const f32x4*)(convw + j), g1 = *(const f32x4*)(convw + NUP + j), g2 = *(const f32x4*)(convw + 2 * NUP + j), gb = *(const f32x4*)(convb + j);
            const f32x4 v0 = *(const f32x4*)(convw + DFF + j), v1 = *(const f32x4*)(convw + NUP + DFF + j), v2 = *(const f32x4*)(convw + 2 * NUP + DFF + j), vb = *(const f32x4*)(convb + DFF + j);
            const size_t ecol = (size_t)u.pn * 256 + (bj + hb) * 128 + wc * 32 + 8 * fq;
#pragma unroll
            for (int ai = 0; ai < 2; ++ai) {
                const int blk = u.pm * 4 + ai * 2 + wr;
                f32x4 pg1, pg2, pv1, pv2;
                pg1 = pg2 = pv1 = pv2 = (f32x4){0.f, 0.f, 0.f, 0.f};
#pragma unroll
                for (int m = 0; m < 4; ++m) {
                    const int row = row0 + ai * 128 + m * 16;
                    const float rs = rst[wr * 64 + fr + ai * 128 + m * 16];
                    const f32x4 ug = acc[ai][bj][m][0] * rs, uv = acc[ai][bj][m][1] * rs;
                    f32x4 rg1, rg2, rv1, rv2;
#pragma unroll
                    for (int e = 0; e < 4; ++e) { rg1[e] = dpp_ror<1>(ug[e]); rg2[e] = dpp_ror<2>(ug[e]); rv1[e] = dpp_ror<1>(uv[e]); rv2[e] = dpp_ror<2>(uv[e]); }
                    if (m == 0 && fr < 2) { *(f32x4*)(edge + ((size_t)blk * 4 + fr) * NUP + ecol) = ug; *(f32x4*)(edge + ((size_t)blk * 4 + fr) * NUP + ecol + 4) = uv; }
                    if (m == 3 && fr >= 14) { *(f32x4*)(edge + ((size_t)blk * 4 + (fr - 12)) * NUP + ecol) = ug; *(f32x4*)(edge + ((size_t)blk * 4 + (fr - 12)) * NUP + ecol + 4) = uv; }
                    const f32x4 qg1 = (fr >= 1) ? rg1 : pg1, qg2 = (fr >= 2) ? rg2 : pg2, qv1 = (fr >= 1) ? rv1 : pv1, qv2 = (fr >= 2) ? rv2 : pv2;
                    const f32x4 cg = gb + g2 * ug + g1 * qg1 + g0 * qg2, cv = vb + v2 * uv + v1 * qv1 + v0 * qv2;
                    if (!(m == 0 && fr < 2)) {
                        f32x4 o;
#pragma unroll
                        for (int e = 0; e < 4; ++e) o[e] = cg[e] * sigmoidf_(cg[e]) * cv[e];
                        u32x2 w; w.x = cvtpk(o[0], o[1]); w.y = cvtpk(o[2], o[3]);
                        *(u32x2*)(act + (size_t)row * DFF + j) = w;
                    }
                    pg1 = rg1; pg2 = rg2; pv1 = rv1; pv2 = rv2;
                }
            }
        }
    }
};

struct TItem { f32x4 v[8]; float g[8]; int k0, n0; };
__device__ __forceinline__ void titem_load(TItem& t, const float* W, int N, int item, int lane, const float* gain) {
    const int nblk = N / 32, kb = item / nblk, nb = item % nblk; t.k0 = 64 * kb; t.n0 = 32 * nb;
#pragma unroll
    for (int i = 0; i < 8; ++i) t.v[i] = *(const f32x4*)(W + (size_t)(t.k0 + (lane >> 3) + 8 * i) * N + t.n0 + 4 * (lane & 7));
#pragma unroll
    for (int i = 0; i < 8; ++i) t.g[i] = gain ? gain[t.k0 + (lane >> 3) + 8 * i] : 1.0f;
}
__device__ __forceinline__ void titem_store(const TItem& t, int K, bf16_t* WT, int lane, LAS float* scr, int mode) {
#pragma unroll
    for (int i = 0; i < 8; ++i) { const int kk = (lane >> 3) + 8 * i; const float gn = t.g[i]; LAS float* d = scr + kk * 33 + 4 * (lane & 7);
        d[0] = t.v[i].x * gn; d[1] = t.v[i].y * gn; d[2] = t.v[i].z * gn; d[3] = t.v[i].w * gn; }
    asm volatile("s_waitcnt lgkmcnt(0)" ::: "memory");
    const int k0 = t.k0, n0 = t.n0;
    int drow0 = n0;
    if (mode == 1) { const int j0 = (n0 < DFF) ? n0 : n0 - DFF; drow0 = 256 * (j0 >> 7) + 2 * (j0 & 127) + ((n0 < DFF) ? 0 : 4); }
    const int c = lane & 7;
#pragma unroll
    for (int jj = 0; jj < 4; ++jj) { const int n = (lane >> 3) + 8 * jj; const LAS float* s = scr + (8 * c) * 33 + n;
        u32x4 o; o.x = cvtpk(s[0 * 33], s[1 * 33]); o.y = cvtpk(s[2 * 33], s[3 * 33]); o.z = cvtpk(s[4 * 33], s[5 * 33]); o.w = cvtpk(s[6 * 33], s[7 * 33]);
        *(u32x4*)(WT + (size_t)(drow0 + (mode == 1 ? 8 * (n >> 2) + (n & 3) : n)) * K + k0 + 8 * c) = o; }
    asm volatile("s_waitcnt lgkmcnt(0)" ::: "memory");
}
__device__ __forceinline__ void convert_weight(const float* W, int K, int N, bf16_t* WT, const float* gain, int mode, LAS unsigned char* lds, int wave, int lane, int gw, int NGW) {
    LAS float* scr = (LAS float*)(lds + wave * 16896);
    const int nitems = (K / 64) * (N / 32);
    for (int it = gw; it < nitems; it += 2 * NGW) {
        TItem ta, tb; const bool two = (it + NGW) < nitems;
        titem_load(ta, W, N, it, lane, gain);
        if (two) titem_load(tb, W, N, it + NGW, lane, gain);
        titem_store(ta, K, WT, lane, scr, mode);
        if (two) titem_store(tb, K, WT, lane, scr + 2112, mode);
    }
}
__device__ __forceinline__ float wave_sum(float v) {
#pragma unroll
    for (int o = 1; o < 64; o <<= 1) v += __shfl_xor(v, o);
    return v;
}

struct Pair2 { float lo, hi; };
__device__ __forceinline__ Pair2 row_pair16(float m) { auto r = __builtin_amdgcn_permlane16_swap(__float_as_uint(m), __float_as_uint(m), false, false); return Pair2{__uint_as_float(r[0]), __uint_as_float(r[1])}; }
__device__ __forceinline__ Pair2 half_pair32(float m) { auto r = __builtin_amdgcn_permlane32_swap(__float_as_uint(m), __float_as_uint(m), false, false); return Pair2{__uint_as_float(r[0]), __uint_as_float(r[1])}; }
__device__ __forceinline__ float quads_sum(float v) { const Pair2 a = row_pair16(v); const Pair2 b = half_pair32(a.lo + a.hi); return b.lo + b.hi; }
__device__ __forceinline__ float quads_max(float v) { const Pair2 a = row_pair16(v); const Pair2 b = half_pair32(fmaxf(a.lo, a.hi)); return fmaxf(b.lo, b.hi); }
template <int CTRL> __device__ __forceinline__ float dpp_f(float v) { return __builtin_bit_cast(float, __builtin_amdgcn_update_dpp(0, __builtin_bit_cast(int, v), CTRL, 0xF, 0xF, false)); }
__device__ __forceinline__ float oct_sum(float v) { v += dpp_f<0xB1>(v); v += dpp_f<0x4E>(v); v += dpp_f<0x141>(v); return v; }
#define MFMA16(a, b, c) __builtin_amdgcn_mfma_f32_16x16x32_bf16((a), (b), (c), 0, 0, 0)
__device__ __forceinline__ void unpack8(const u32x4 w, float (&f)[8]) { f[0] = bf_lo(w.x); f[1] = bf_hi(w.x); f[2] = bf_lo(w.y); f[3] = bf_hi(w.y); f[4] = bf_lo(w.z); f[5] = bf_hi(w.z); f[6] = bf_lo(w.w); f[7] = bf_hi(w.w); }
__device__ __forceinline__ u32x4 pack8(const float (&f)[8]) { u32x4 w; w.x = cvtpk(f[0], f[1]); w.y = cvtpk(f[2], f[3]); w.z = cvtpk(f[4], f[5]); w.w = cvtpk(f[6], f[7]); return w; }

template <int WIN> __device__ __forceinline__ void pool_rows(const bf16_t* UC, bf16_t* OC, int t, int cofs) {
    const int pos = t & (SEQ - 1);
    u32x4 v[WIN];
#pragma unroll
    for (int i = 0; i < WIN; ++i) { const bool ok = i <= pos; v[i] = *(const u32x4*)(UC + (size_t)(ok ? t - i : t) * 512 + cofs); }
    float cur[8], sum[8]; unpack8(v[0], cur);
#pragma unroll
    for (int e = 0; e < 8; ++e) sum[e] = cur[e];
#pragma unroll
    for (int i = 1; i < WIN; ++i) { float f[8]; unpack8(v[i], f); const float wgt = (i <= pos) ? 1.f : 0.f;
#pragma unroll
        for (int e = 0; e < 8; ++e) sum[e] += wgt * f[e]; }
    const int n = (pos + 1 < WIN) ? pos + 1 : WIN; const float invn = 1.0f / (float)n;
#pragma unroll
    for (int e = 0; e < 8; ++e) sum[e] = sum[e] * invn - cur[e];
    *(u32x4*)(OC + (size_t)t * 512 + cofs) = pack8(sum);
}

constexpr int A_KS = 0, A_KSTRIDE = 528, A_VT = 67584, A_VSTRIDE = 528, A_RB = 135168, A_BUF = 33792;
typedef short v4i16_t __attribute__((ext_vector_type(4)));
__device__ __forceinline__ v4i16_t lds_tr16(const LAS unsigned char* p) { return __builtin_amdgcn_ds_read_tr16_b64_v4i16((LAS v4i16_t*)p); }
template <int WIN> __device__ __forceinline__ void pool_rows2(const bf16_t* UC, bf16_t* OC, int ta, int tb, int cofs) {
    const int posa = ta & (SEQ - 1), posb = tb & (SEQ - 1);
    u32x4 va[WIN], vb[WIN];
#pragma unroll
    for (int i = 0; i < WIN; ++i) { va[i] = *(const u32x4*)(UC + (size_t)((i <= posa) ? ta - i : ta) * 512 + cofs); }
#pragma unroll
    for (int i = 0; i < WIN; ++i) { vb[i] = *(const u32x4*)(UC + (size_t)((i <= posb) ? tb - i : tb) * 512 + cofs); }
#pragma unroll
    for (int h = 0; h < 2; ++h) {
        const int pos = h ? posb : posa, t = h ? tb : ta;
        float cur[8], sum[8]; unpack8(h ? vb[0] : va[0], cur);
#pragma unroll
        for (int e = 0; e < 8; ++e) sum[e] = cur[e];
#pragma unroll
        for (int i = 1; i < WIN; ++i) { float f[8]; unpack8(h ? vb[i] : va[i], f); const float wgt = (i <= pos) ? 1.f : 0.f;
#pragma unroll
            for (int e = 0; e < 8; ++e) sum[e] += wgt * f[e]; }
        const int n = (pos + 1 < WIN) ? pos + 1 : WIN; const float invn = 1.0f / (float)n;
#pragma unroll
        for (int e = 0; e < 8; ++e) sum[e] = sum[e] * invn - cur[e];
        *(u32x4*)(OC + (size_t)t * 512 + cofs) = pack8(sum);
    }
}
__device__ __forceinline__ void sm_chain(f32x4 (&s)[4], int j, int qi, int quad, const LAS float* rbh, float& m_run, float& l_run, f32x4 (&O)[4], bf16x8 (&pb)[2]) {
    if (j >= 6) {
        const int dbase = qi + 64 * (8 - j) + 63;
#pragma unroll
        for (int t = 0; t < 4; ++t)
#pragma unroll
            for (int e = 0; e < 4; ++e) { const int ki = 16 * t + 4 * quad + e; int idx = dbase - ki; idx = idx > 191 ? 191 : idx; s[t][e] += rbh[idx]; }
    }
    float mx = fmaxf(fmaxf(s[0][0], s[0][1]), fmaxf(s[0][2], s[0][3]));
#pragma unroll
    for (int t = 1; t < 4; ++t) mx = fmaxf(mx, fmaxf(fmaxf(s[t][0], s[t][1]), fmaxf(s[t][2], s[t][3])));
    mx = quads_max(mx);
    const float m_new = fmaxf(m_run, mx), alpha = __builtin_amdgcn_exp2f(m_run - m_new);
    float ps = 0.f;
#pragma unroll
    for (int t = 0; t < 4; ++t)
#pragma unroll
        for (int e = 0; e < 4; ++e) { s[t][e] = __builtin_amdgcn_exp2f(s[t][e] - m_new); ps += s[t][e]; }
    l_run = l_run * alpha + ps; m_run = m_new;
    if (__any(alpha != 1.0f)) {
#pragma unroll
        for (int d = 0; d < 4; ++d) O[d] *= alpha;
    }
#pragma unroll
    for (int s2 = 0; s2 < 2; ++s2) { u32x4 w; w.x = cvtpk(s[2 * s2][0], s[2 * s2][1]); w.y = cvtpk(s[2 * s2][2], s[2 * s2][3]); w.z = cvtpk(s[2 * s2 + 1][0], s[2 * s2 + 1][1]); w.w = cvtpk(s[2 * s2 + 1][2], s[2 * s2 + 1][3]); pb[s2] = __builtin_bit_cast(bf16x8, w); }
}
__device__ __forceinline__ void attnA_unit(int b, int c, int hq, unsigned char* ws, const float* gq, const float* gk, const float* rb, LAS unsigned char* L, int store) {
    int tid = threadIdx.x; asm volatile("" : "+v"(tid));
    const int lane = tid & 63, wid = __builtin_amdgcn_readfirstlane(tid >> 6), hl = wid >> 1, qp = wid & 1, fr = lane & 15, quad = lane >> 4;
    const int h = hq * 4 + hl;
    bf16_t* QA = (bf16_t*)(ws + WS_QA); const bf16_t* KA = (const bf16_t*)(ws + WS_KA); const bf16_t* VA = (const bf16_t*)(ws + WS_VA);
    const int R0 = b * SEQ + c * 64;
    const int qrow = R0 + qp * 32 + fr;
    const int jlo = (c >= 8) ? 0 : 8 - c;
    u32x4 kreg[4], vreg[4];
    const int srow0 = tid >> 5, sch = tid & 31;
#define A_FETCH(jj) do { const size_t rk_ = (size_t)(b * SEQ + (c + (jj) - 8) * 64); _Pragma("unroll") for (int i = 0; i < 4; ++i) { \
        const size_t off_ = (rk_ + srow0 + 16 * i) * 512 + hq * 256 + sch * 8; kreg[i] = *(const u32x4*)(KA + off_); vreg[i] = *(const u32x4*)(VA + off_); } } while (0)
#define A_STAGE(bufo) do { _Pragma("unroll") for (int i = 0; i < 4; ++i) { const int row_ = srow0 + 16 * i; float f_[8]; unpack8(kreg[i], f_); float ss_ = 0.f; \
        _Pragma("unroll") for (int e = 0; e < 8; ++e) ss_ += f_[e] * f_[e]; \
        ss_ = oct_sum(ss_); const float rs_ = rsqrtf(ss_ * (1.0f / 64.0f) + EPS); \
        _Pragma("unroll") for (int e = 0; e < 8; ++e) f_[e] *= rs_; \
        *(LAS u32x4*)(L + A_KS + (bufo) + row_ * A_KSTRIDE + sch * 16) = pack8(f_); \
        *(LAS u32x4*)(L + A_VT + (bufo) + row_ * A_VSTRIDE + sch * 16) = vreg[i]; } } while (0)
    A_FETCH(jlo);
    LAS float* rbs = (LAS float*)(L + A_RB);
    const float rb_a = rb[(hq * 4) * 192 + tid], rb_b = (tid < 256) ? rb[(hq * 4) * 192 + 512 + tid] : 0.f;
    bf16x8 qf[2][2];
#pragma unroll
    for (int i = 0; i < 2; ++i) {
        const bf16_t* qptr = QA + (size_t)(qrow + 16 * i) * 512 + h * 64 + quad * 8;
        const u32x4 w0 = *(const u32x4*)qptr, w1 = *(const u32x4*)(qptr + 32);
        float f0[8], f1[8]; unpack8(w0, f0); unpack8(w1, f1);
        float ss = 0.f;
#pragma unroll
        for (int e = 0; e < 8; ++e) ss += f0[e] * f0[e] + f1[e] * f1[e];
        ss = quads_sum(ss);
        const float rs = rsqrtf(ss * (1.0f / 64.0f) + EPS) * (0.125f * 1.4426950408889634f);
#pragma unroll
        for (int e = 0; e < 8; ++e) { f0[e] *= rs * gq[quad * 8 + e] * gk[quad * 8 + e]; f1[e] *= rs * gq[32 + quad * 8 + e] * gk[32 + quad * 8 + e]; }
        qf[i][0] = __builtin_bit_cast(bf16x8, pack8(f0)); qf[i][1] = __builtin_bit_cast(bf16x8, pack8(f1));
    }
    rbs[tid] = rb_a * 1.4426950408889634f; if (tid < 256) rbs[512 + tid] = rb_b * 1.4426950408889634f;
    A_STAGE(0);
    if (jlo < 8) A_FETCH(jlo + 1);
    float m0 = -1e30f, m1 = -1e30f, l0 = 0.f, l1 = 0.f;
    f32x4 O0[4], O1[4];
#pragma unroll
    for (int d = 0; d < 4; ++d) { O0[d] = (f32x4){0.f, 0.f, 0.f, 0.f}; O1[d] = (f32x4){0.f, 0.f, 0.f, 0.f}; }
    __syncthreads();
    for (int j = jlo; j <= 8; ++j) {
        const int bufo = ((j - jlo) & 1) * A_BUF;
        if (j < 8) { A_STAGE(A_BUF - bufo); if (j < 7) A_FETCH(j + 2); }
        f32x4 s0[4], s1[4];
        const LAS float* rbh = rbs + hl * 192;
        const float bc0 = (j >= 6) ? 0.f : rbh[191];
#pragma unroll
        for (int t = 0; t < 4; ++t) {
            f32x4 a0 = (f32x4){bc0, bc0, bc0, bc0}, a1 = a0;
#pragma unroll
            for (int ks = 0; ks < 2; ++ks) { const bf16x8 kf = *(const LAS bf16x8*)(L + A_KS + bufo + (16 * t + fr) * A_KSTRIDE + hl * 128 + ks * 64 + quad * 16); a0 = MFMA16(kf, qf[0][ks], a0); a1 = MFMA16(kf, qf[1][ks], a1); }
            s0[t] = a0; s1[t] = a1;
        }
        bf16x8 pb0[2], pb1[2];
        sm_chain(s0, j, qp * 32 + fr, quad, rbh, m0, l0, O0, pb0);
        sm_chain(s1, j, qp * 32 + 16 + fr, quad, rbh, m1, l1, O1, pb1);
#pragma unroll
        for (int dt = 0; dt < 4; ++dt)
#pragma unroll
            for (int s2 = 0; s2 < 2; ++s2) {
                const LAS unsigned char* vp = L + A_VT + bufo + (32 * s2 + 4 * quad + (fr >> 2)) * A_VSTRIDE + (hl * 64 + 16 * dt + 4 * (fr & 3)) * 2;
                const v4i16_t lo = lds_tr16(vp), hi = lds_tr16(vp + 16 * A_VSTRIDE);
                const bf16x8 va = __builtin_shufflevector(lo, hi, 0, 1, 2, 3, 4, 5, 6, 7);
                O0[dt] = MFMA16(va, pb0[s2], O0[dt]); O1[dt] = MFMA16(va, pb1[s2], O1[dt]);
            }
        __syncthreads();
    }
#undef A_FETCH
#undef A_STAGE
    l0 = quads_sum(l0); l1 = quads_sum(l1);
    const float inv0 = 1.0f / l0, inv1 = 1.0f / l1;
    if (store)
#pragma unroll
    for (int dt = 0; dt < 4; ++dt) { u32x2 w; w.x = cvtpk(O0[dt][0] * inv0, O0[dt][1] * inv0); w.y = cvtpk(O0[dt][2] * inv0, O0[dt][3] * inv0);
        *(u32x2*)(QA + (size_t)qrow * 512 + h * 64 + 16 * dt + 4 * quad) = w;
        w.x = cvtpk(O1[dt][0] * inv1, O1[dt][1] * inv1); w.y = cvtpk(O1[dt][2] * inv1, O1[dt][3] * inv1);
        *(u32x2*)(QA + (size_t)(qrow + 16) * 512 + h * 64 + 16 * dt + 4 * quad) = w; }
}

constexpr int B_KS = 0, B_STRIDE = 144, B_VT = 18432, B_FLAGS = 36864, B_BUF = 9216;
__device__ __forceinline__ void attnB_unit(int b, int h, int qb, unsigned char* ws, LAS unsigned char* L, int store) {
    int tid = threadIdx.x; asm volatile("" : "+v"(tid));
    const int lane = tid & 63, wid = __builtin_amdgcn_readfirstlane(tid >> 6), fr = lane & 15, quad = lane >> 4;
    bf16_t* QB = (bf16_t*)(ws + WS_QB); const bf16_t* KB = (const bf16_t*)(ws + WS_KB); const bf16_t* VB = (const bf16_t*)(ws + WS_VB);
    const int q0 = qb * 128, qpos = q0 + wid * 16 + fr;
    const size_t qrow = (size_t)b * SEQ + qpos;
    const int srow = tid >> 3, sch = tid & 7;
    int kt = 2 * qb + 1;
    u32x4 kreg, vreg;
    { const size_t off = ((size_t)b * SEQ + kt * 64 + srow) * 512 + h * 64 + sch * 8; kreg = *(const u32x4*)(KB + off); vreg = *(const u32x4*)(VB + off); }
    bf16x8 qf[2];
    {
        const bf16_t* qp = QB + qrow * 512 + h * 64 + quad * 8;
        const u32x4 w0 = *(const u32x4*)qp, w1 = *(const u32x4*)(qp + 32);
        float f0[8], f1[8]; unpack8(w0, f0); unpack8(w1, f1);
#pragma unroll
        for (int e = 0; e < 8; ++e) { f0[e] *= 0.125f * 1.4426950408889634f; f1[e] *= 0.125f * 1.4426950408889634f; }
        qf[0] = __builtin_bit_cast(bf16x8, pack8(f0)); qf[1] = __builtin_bit_cast(bf16x8, pack8(f1));
    }
    LAS int* flags = (LAS int*)(L + B_FLAGS);
    if (tid < 160) flags[tid] = 0;
    float carry = 0.f; bool wave_done = false;
    f32x4 O[4];
#pragma unroll
    for (int d = 0; d < 4; ++d) O[d] = (f32x4){0.f, 0.f, 0.f, 0.f};
    const int wave_qmax = q0 + wid * 16 + 15;
#define B_FETCH(kk) do { const size_t off_ = ((size_t)b * SEQ + (kk) * 64 + srow) * 512 + h * 64 + sch * 8; kreg = *(const u32x4*)(KB + off_); vreg = *(const u32x4*)(VB + off_); } while (0)
#define B_STAGE(bufo_) do { *(LAS u32x4*)(L + B_KS + (bufo_) + srow * B_STRIDE + sch * 16) = kreg; *(LAS u32x4*)(L + B_VT + (bufo_) + srow * B_STRIDE + sch * 16) = vreg; } while (0)
    B_STAGE(0);
    if (kt > 0) B_FETCH(kt - 1);
    __syncthreads();
    for (int it = 0;; ++it) {
        const int bufo = (it & 1) * B_BUF;
        if (kt > 0) { B_STAGE(B_BUF - bufo); if (kt > 1) B_FETCH(kt - 2); }
        const int kbase = kt * 64;
        if (!wave_done && kbase < wave_qmax) {
            f32x4 z[4];
#pragma unroll
            for (int t = 0; t < 4; ++t) {
                f32x4 a = (f32x4){0.f, 0.f, 0.f, 0.f};
#pragma unroll
                for (int ks = 0; ks < 2; ++ks) { const bf16x8 kf = *(const LAS bf16x8*)(L + B_KS + bufo + (16 * t + fr) * B_STRIDE + ks * 64 + quad * 16); a = MFMA16(kf, qf[ks], a); }
                z[t] = a;
            }
            f32x4 lk[4];
            if (kbase + 64 <= q0 + wid * 16) {
#pragma unroll
                for (int t = 0; t < 4; ++t)
#pragma unroll
                    for (int e = 0; e < 4; ++e) {
                        const float zz = z[t][e];
                        lk[t][e] = -(fmaxf(zz, 0.f) + __builtin_amdgcn_logf(1.0f + __builtin_amdgcn_exp2f(-fabsf(zz))));
                    }
            } else {
#pragma unroll
                for (int t = 0; t < 4; ++t)
#pragma unroll
                    for (int e = 0; e < 4; ++e) {
                        const float zz = z[t][e]; const bool before = (kbase + 16 * t + 4 * quad + e) < qpos;
                        const float v = -(fmaxf(zz, 0.f) + __builtin_amdgcn_logf(1.0f + __builtin_amdgcn_exp2f(-fabsf(zz))));
                        lk[t][e] = before ? v : 0.f;
                        z[t][e] = before ? zz : -1e30f;
                    }
            }
            float run = carry;
            f32x4 w[4];
#pragma unroll
            for (int t = 3; t >= 0; --t) {
                const float s3 = lk[t][3], s2 = s3 + lk[t][2], s1 = s2 + lk[t][1], s0 = s1 + lk[t][0];
                const Pair2 r16 = row_pair16(s0); const float pair = r16.lo + r16.hi; const Pair2 r32 = half_pair32(pair); const float tot = r32.lo + r32.hi;
                const float ex = ((quad & 1) ? 0.f : r16.hi) + ((quad & 2) ? 0.f : r32.hi) + run;
                w[t][0] = __builtin_amdgcn_exp2f((z[t][0] + ex) + s0); w[t][1] = __builtin_amdgcn_exp2f((z[t][1] + ex) + s1); w[t][2] = __builtin_amdgcn_exp2f((z[t][2] + ex) + s2); w[t][3] = __builtin_amdgcn_exp2f((z[t][3] + ex) + s3);
                run += tot;
            }
            carry = run;
            bf16x8 pb[2];
#pragma unroll
            for (int s2 = 0; s2 < 2; ++s2) { u32x4 ww; ww.x = cvtpk(w[2 * s2][0], w[2 * s2][1]); ww.y = cvtpk(w[2 * s2][2], w[2 * s2][3]); ww.z = cvtpk(w[2 * s2 + 1][0], w[2 * s2 + 1][1]); ww.w = cvtpk(w[2 * s2 + 1][2], w[2 * s2 + 1][3]); pb[s2] = __builtin_bit_cast(bf16x8, ww); }
#pragma unroll
            for (int dt = 0; dt < 4; ++dt)
#pragma unroll
                for (int s2 = 0; s2 < 2; ++s2) {
                    const LAS unsigned char* vp = L + B_VT + bufo + (32 * s2 + 4 * quad + (fr >> 2)) * B_STRIDE + (16 * dt + 4 * (fr & 3)) * 2;
                    const v4i16_t lo = lds_tr16(vp), hi = lds_tr16(vp + 16 * B_STRIDE);
                    const bf16x8 va = __builtin_shufflevector(lo, hi, 0, 1, 2, 3, 4, 5, 6, 7);
                    O[dt] = MFMA16(va, pb[s2], O[dt]);
                }
#if EARLY_EXIT
            wave_done = __all(carry < -105.0f * 1.4426950408889634f) != 0;
#endif
        }
        if (!wave_done && lane == 0) flags[it] = 1;
        __syncthreads();
        const int cont = flags[it];
        if (kt == 0 || !cont) break;
        --kt;
    }
    if (store)
#pragma unroll
    for (int dt = 0; dt < 4; ++dt) { u32x2 w; w.x = cvtpk(O[dt][0], O[dt][1]); w.y = cvtpk(O[dt][2], O[dt][3]);
        *(u32x2*)(QB + qrow * 512 + h * 64 + 16 * dt + 4 * quad) = w; }
#undef B_FETCH
#undef B_STAGE
}


#define XB_TMO      128
#define XB_XCNT(j)  (256  + 64 * (j))
#define XB_XSUB(j)  (1280 + 64 * (j))
#define XB_XGEN(j)  (2304 + 64 * (j))
#define XB_TOP      3328
#define XB_TOPGEN   3392
#define XCD_BAR_WORDS 3456
#define XB_SPIN_CAP (1u << 18)
__device__ __forceinline__ unsigned xb_ld(unsigned* p)              { return __hip_atomic_load(p, __ATOMIC_RELAXED, __HIP_MEMORY_SCOPE_AGENT); }
__device__ __forceinline__ unsigned xb_add(unsigned* p, unsigned v) { return __hip_atomic_fetch_add(p, v, __ATOMIC_RELAXED, __HIP_MEMORY_SCOPE_AGENT); }
__device__ __forceinline__ unsigned xb_xcc_id() { return (unsigned)__builtin_amdgcn_s_getreg((3 << 11) | 20) & 0xFu; }
#define XB_SPIN(cond, bar) do { unsigned _sp = 0; while (cond) { __builtin_amdgcn_s_sleep(1); \
    if ((++_sp & 255u) == 0u) { if (xb_ld(&(bar)[XB_TMO])) break; if (_sp > XB_SPIN_CAP) { atomicAdd(&(bar)[XB_TMO], 1u); break; } } } } while (0)
struct XcdBarrier { unsigned* bar; unsigned x; volatile LAS unsigned* st; };
__device__ __forceinline__ XcdBarrier xcd_barrier_post(unsigned* bar, volatile LAS unsigned* st) {
    XcdBarrier b; b.bar = bar; b.x = xb_xcc_id(); b.st = st;
    if (threadIdx.x == 0) (void)xb_add(&bar[XB_XCNT(b.x)], 1u);
    return b;
}
__device__ __forceinline__ void xcd_barrier_complete(unsigned* bar, unsigned x, unsigned& nloc, unsigned& nx) {
    const unsigned G = gridDim.x * gridDim.y * gridDim.z;
    unsigned sum, cnt, mine, sp = 0u;
    for (;;) {
        sum = 0u; cnt = 0u; mine = 0u;
#pragma unroll
        for (unsigned j = 0; j < 16; ++j) { const unsigned c = xb_ld(&bar[XB_XCNT(j)]); sum += c; cnt += (c > 0u) ? 1u : 0u; mine = (j == x) ? c : mine; }
        if (sum == G) break;
        __builtin_amdgcn_s_sleep(1);
        if ((++sp & 255u) == 0u) { if (xb_ld(&bar[XB_TMO])) break; if (sp > XB_SPIN_CAP) { atomicAdd(&bar[XB_TMO], 1u); break; } }
    }
    nloc = mine > 0u ? mine : 1u; nx = cnt > 0u ? cnt : 1u;
}
__device__ __forceinline__ void xcd_barrier(const XcdBarrier& b) {
    asm volatile("s_waitcnt vmcnt(0)" ::: "memory");
    __syncthreads();
    if (threadIdx.x == 0) {
        unsigned* bar = b.bar;
        __builtin_amdgcn_s_waitcnt(0);
        unsigned nloc = b.st[0], nx = b.st[1];
        if (nloc == 0u) { xcd_barrier_complete(bar, b.x, nloc, nx); b.st[0] = nloc; b.st[1] = nx; }
        const unsigned old = xb_add(&bar[XB_XSUB(b.x)], 1u);
        const unsigned gen = old / nloc;
        if (old + 1u == (gen + 1u) * nloc) {
            __builtin_amdgcn_fence(__ATOMIC_RELEASE, "agent");
            asm volatile("s_waitcnt vmcnt(0)" ::: "memory");
            const unsigned og = xb_add(&bar[XB_TOP], 1u);
            const unsigned tg = og / nx;
            if (og + 1u == (tg + 1u) * nx) xb_add(&bar[XB_TOPGEN], 1u);
            else XB_SPIN(xb_ld(&bar[XB_TOPGEN]) == tg, bar);
            __builtin_amdgcn_fence(__ATOMIC_ACQUIRE, "agent");
            xb_add(&bar[XB_XGEN(b.x)], 1u);
            asm volatile("s_waitcnt vmcnt(0)" ::: "memory");
        } else {
            XB_SPIN(xb_ld(&bar[XB_XGEN(b.x)]) == gen, bar);
            __builtin_amdgcn_fence(__ATOMIC_ACQUIRE, "agent");
            asm volatile("s_waitcnt vmcnt(0)" ::: "memory");
        }
    }
    __syncthreads();
}

struct Args { const float* in[18]; float* out; unsigned char* ws; };

__global__ void __launch_bounds__(512, 2) fwd_megakernel(Args a) {
    extern __shared__ __attribute__((aligned(16))) unsigned char lds_raw[];
    LAS unsigned char* lds = (LAS unsigned char*)lds_raw;
    cg::grid_group grid = cg::this_grid();
    const int G = gridDim.x, bx = blockIdx.x;
    const int vcu = (G % 8 == 0) ? (bx % 8) * (G / 8) + bx / 8 : bx;
    const int NGW = G * 8, NGT = G * 512;
#define PHASE_IDS int tid = threadIdx.x; asm volatile("" : "+v"(tid)); const int lane = tid & 63, wave = __builtin_amdgcn_readfirstlane(tid >> 6), gw = vcu * 8 + wave, gt = vcu * 512 + tid; (void)lane; (void)gw; (void)gt;
    unsigned char* ws = a.ws;
    {
        if (threadIdx.x < 2) ((volatile LAS unsigned*)(lds + XB_LDS_OFF))[threadIdx.x] = 0u;
        __syncthreads();
    }
    const XcdBarrier xbar = xcd_barrier_post((unsigned*)(ws + WS_BAR), (volatile LAS unsigned*)(lds + XB_LDS_OFF));
    float* stat = (float*)(ws + WS_STAT);
    bf16_t* XB = (bf16_t*)(ws + WS_XB);

    {
    PHASE_IDS
    for (int rep = 0; rep < REP_MISC; ++rep) {
    convert_weight(a.in[2], DM, NIN, (bf16_t*)(ws + WS_WIN), a.in[1], 0, lds, wave, lane, gw, NGW);
    for (int m0 = gw; m0 < T; m0 += 8 * NGW) {
        f32x4 v[8][4]; float s[8];
#pragma unroll
        for (int r = 0; r < 8; ++r) { const int m = m0 + r * NGW; const f32x4* xr = (const f32x4*)(a.in[0] + (size_t)(m < T ? m : 0) * DM) + lane;
#pragma unroll
            for (int j = 0; j < 4; ++j) v[r][j] = xr[64 * j]; }
#pragma unroll
        for (int r = 0; r < 8; ++r) { float ss = 0.f;
#pragma unroll
            for (int j = 0; j < 4; ++j) ss += (v[r][j].x * v[r][j].x + v[r][j].y * v[r][j].y) + (v[r][j].z * v[r][j].z + v[r][j].w * v[r][j].w);
            s[r] = wave_sum(ss); }
#pragma unroll
        for (int r = 0; r < 8; ++r) { const int m = m0 + r * NGW; if (m < T) {
            u32x2* o8 = (u32x2*)(XB + (size_t)m * DM) + lane;
#pragma unroll
            for (int j = 0; j < 4; ++j) { u32x2 w; w.x = cvtpk(v[r][j].x, v[r][j].y); w.y = cvtpk(v[r][j].z, v[r][j].w); o8[64 * j] = w; }
            if (lane < 16) stat[(size_t)m * 16 + lane] = (lane == 0) ? s[r] : 0.f; } }
    }
    }
    }
    if (a.ws == nullptr) grid.sync();
    {
        int tid = threadIdx.x; asm volatile("" : "+v"(tid));
        if (tid < 64) {
            unsigned* bar = xbar.bar; unsigned sp = 0u, c, sum, cnt, mine;
            for (;;) {
                c = (tid < 16) ? xb_ld(&bar[XB_XCNT(tid)]) : 0u;
                sum = c;
#pragma unroll
                for (int o = 1; o < 16; o <<= 1) sum += (unsigned)__shfl_xor((int)sum, o);
                sum = (unsigned)__shfl((int)sum, 0);
                cnt = (unsigned)__builtin_popcountll(__ballot(c > 0u));
                mine = (unsigned)__shfl((int)c, (int)xbar.x);
                if (sum == (unsigned)G) break;
                __builtin_amdgcn_s_sleep(1);
                if ((++sp & 255u) == 0u) { if (xb_ld(&bar[XB_TMO])) break; if (sp > XB_SPIN_CAP) { if (tid == 0) atomicAdd(&bar[XB_TMO], 1u); break; } }
            }
            if (tid == 0) { xbar.st[0] = mine > 0u ? mine : 1u; xbar.st[1] = cnt > 0u ? cnt : 1u; }
        }
        __syncthreads();
    }
    GRID_SYNC();

    for (int l = 0; l < NL; ++l) {
        const float* xres = (l == 0) ? a.in[0] : a.out;
        {
            const bf16_t* xin16 = (l == 0) ? XB : (const bf16_t*)a.out;
            pg8::Gemm g; g.A0 = g.A1 = g.A2 = xin16; g.B0 = g.B1 = g.B2 = (const bf16_t*)(ws + WS_WIN); g.lda = DM; g.ldb = DM; g.K = DM;
            pg8::Order<T, NIN, 1, 1> S; S.init(G, bx);
            EpiProj E{ws, stat, a.in[3] + (size_t)l * 3072};
            for (int rep = 0; rep < REP_G1; ++rep) pg8::gemm_phase(lds, g, S, E);
        }
        GRID_SYNC();
        {
            PHASE_IDS
            for (int rep = 0; rep < REP_MISC; ++rep) {
            convert_weight(a.in[9] + (size_t)l * 512 * 1024, 512, 1024, (bf16_t*)(ws + WS_WA), nullptr, 0, lds, wave, lane, gw, NGW);
            convert_weight(a.in[10] + (size_t)l * 512 * 1024, 512, 1024, (bf16_t*)(ws + WS_WB), nullptr, 0, lds, wave, lane, gw, NGW);
            convert_weight(a.in[12] + (size_t)l * 1024 * 1024, 1024, 1024, (bf16_t*)(ws + WS_WOUT), nullptr, 0, lds, wave, lane, gw, NGW);
            convert_weight(a.in[14] + (size_t)l * DM * NUP, DM, NUP, (bf16_t*)(ws + WS_WUP), a.in[13] + (size_t)l * DM, 1, lds, wave, lane, gw, NGW);
            {
                const float* Wc = a.in[11] + (size_t)l * 512 * 1024; const float* wp = a.in[7] + (size_t)l * 4 * 128 * 128; const float* sc = a.in[8] + (size_t)l * 512;
                bf16_t* WcT = (bf16_t*)(ws + WS_WC);
                for (int wi = gw; wi < 2048; wi += NGW) {
                    const int n = (wi & 15) * 64 + lane, gc = wi >> 4, gidx = gc >> 5, c4 = gc & 31;
                    const float* wcp = Wc + (size_t)(gidx * 128) * 1024 + n; const float* scp = sc + gidx * 128; const float* wpp = wp + (size_t)(gidx * 128 + c4 * 4) * 128;
                    float acc4[4] = {0.f, 0.f, 0.f, 0.f};
                    for (int e0 = 0; e0 < 128; e0 += 64) {
                        float wcv[64];
#pragma unroll
                        for (int k = 0; k < 64; ++k) wcv[k] = wcp[(size_t)(e0 + k) * 1024];
#pragma unroll
                        for (int k = 0; k < 64; ++k) wcv[k] *= scp[e0 + k];
#pragma unroll
                        for (int jj = 0; jj < 4; ++jj)
#pragma unroll
                            for (int k = 0; k < 64; ++k) acc4[jj] += wpp[jj * 128 + e0 + k] * wcv[k];
                    }
                    u32x2 w; w.x = cvtpk(acc4[0], acc4[1]); w.y = cvtpk(acc4[2], acc4[3]);
                    *(u32x2*)(WcT + (size_t)n * 512 + gidx * 128 + c4 * 4) = w;
                }
            }
            }
            __syncthreads();
            for (int rep = 0; rep < REP_A; ++rep)
            for (int u = vcu; u < 512; u += G) {
                const int c = u & 127, hq = (u >> 7) & 1, b = u >> 8;
                attnA_unit(b, c, hq, ws, a.in[4] + l * 64, a.in[5] + l * 64, a.in[6] + (size_t)l * 8 * 192, lds, rep == REP_A - 1);
            }
            for (int rep = 0; rep < REP_B; ++rep)
            for (int u = vcu; u < 1024; u += G) {
                const int qb = u & 63, h = (u >> 6) & 7, b = u >> 9;
                attnB_unit(b, h, qb, ws, lds, rep == REP_B - 1);
            }
            {
                const bf16_t* UC = (const bf16_t*)(ws + WS_UC); bf16_t* OC = (bf16_t*)(ws + WS_OC);
                for (int rep = 0; rep < REP_MISC; ++rep)
                if (NGW == 2048) {
                for (int wi = gw; wi < T; wi += 2 * NGW) {
                    const int ta = (wi >> 2) * 4 + (lane >> 4), tb = ((wi + NGW) >> 2) * 4 + (lane >> 4), gidx = ((wi & 3) + (wi >> 12)) & 3, cofs = gidx * 128 + (lane & 15) * 8;
                    if (gidx == 0) pool_rows2<2>(UC, OC, ta, tb, cofs); else if (gidx == 1) pool_rows2<4>(UC, OC, ta, tb, cofs); else if (gidx == 2) pool_rows2<8>(UC, OC, ta, tb, cofs); else pool_rows2<16>(UC, OC, ta, tb, cofs);
                }
                } else
                for (int wi = gw; wi < T; wi += NGW) {
                    const int t = (wi >> 2) * 4 + (lane >> 4), gidx = ((wi & 3) + (wi >> 11)) & 3, cofs = gidx * 128 + (lane & 15) * 8;
                    if (gidx == 0) pool_rows<2>(UC, OC, t, cofs); else if (gidx == 1) pool_rows<4>(UC, OC, t, cofs); else if (gidx == 2) pool_rows<8>(UC, OC, t, cofs); else pool_rows<16>(UC, OC, t, cofs);
                }
            }
        }
        GRID_SYNC();
        {
            PHASE_IDS
            for (int rep = 0; rep < REP_MISC; ++rep) convert_weight(a.in[17] + (size_t)l * DFF * DM, DFF, DM, (bf16_t*)(ws + WS_WDN), nullptr, 0, lds, wave, lane, gw, NGW);
            __syncthreads();
            pg8::Gemm g; g.A0 = (const bf16_t*)(ws + WS_QA); g.A1 = (const bf16_t*)(ws + WS_QB); g.A2 = (const bf16_t*)(ws + WS_OC);
            g.B0 = (const bf16_t*)(ws + WS_WA); g.B1 = (const bf16_t*)(ws + WS_WB); g.B2 = (const bf16_t*)(ws + WS_WC); g.lda = 512; g.ldb = 512; g.K = 512;
            pg8::Order<T, DM, 3, 0> S; S.init(G, bx);
            EpiBranch E{(const bf16_t*)(ws + WS_GATES), (bf16_t*)(ws + WS_MERGED)};
            for (int rep = 0; rep < REP_G235; ++rep) pg8::gemm_phase(lds, g, S, E);
        }
        GRID_SYNC();
        {
            pg8::Gemm g; g.A0 = g.A1 = g.A2 = (const bf16_t*)(ws + WS_MERGED); g.B0 = g.B1 = g.B2 = (const bf16_t*)(ws + WS_WOUT); g.lda = DM; g.ldb = DM; g.K = DM;
            pg8::Order<T, DM, 1, 0> S; S.init(G, bx);
            for (int rep = 0; rep < REP_G235; ++rep) { EpiResid E{xres, a.out, (bf16_t*)(ws + WS_X1B), stat, 1, rep == REP_G235 - 1, (l == 0) ? nullptr : (const bf16_t*)a.out, 0};     pg8::gemm_phase(lds, g, S, E); }
        }
        GRID_SYNC();
        {
            pg8::Gemm g; g.A0 = g.A1 = g.A2 = (const bf16_t*)(ws + WS_X1B); g.B0 = g.B1 = g.B2 = (const bf16_t*)(ws + WS_WUP); g.lda = DM; g.ldb = DM; g.K = DM;
            pg8::Order<T, NUP, 1, 1> S; S.init(G, bx);
            EpiUp E{stat, a.in[15] + (size_t)l * 3 * NUP, a.in[16] + (size_t)l * NUP, (bf16_t*)(ws + WS_ACT), (float*)(ws + WS_EDGE)};
            for (int rep = 0; rep < REP_G4; ++rep) pg8::gemm_phase(lds, g, S, E);
            if (l + 1 < NL) {
                pg8::Unit ulast; const int nfull = (T / 256) * (NUP / 256) / G;
                const bool idle = !S.next(nfull, ulast);
                const int nidle = S.halft() ? G : G - ((T / 256) * (NUP / 256) - nfull * G);
                if (nidle == G || idle) {
                    PHASE_IDS
                    const int rank = (nidle == G) ? vcu : (bx - (G - nidle));
                    convert_weight(a.in[2] + (size_t)(l + 1) * DM * NIN, DM, NIN, (bf16_t*)(ws + WS_WIN), a.in[1] + (size_t)(l + 1) * DM, 0, lds, wave, lane, rank * 8 + wave, nidle * 8);
                }
            }
        }
        GRID_SYNC();
        {
            PHASE_IDS
            const float* edge = (const float*)(ws + WS_EDGE); const float* convw = a.in[15] + (size_t)l * 3 * NUP; const float* convb = a.in[16] + (size_t)l * NUP;
            bf16_t* act = (bf16_t*)(ws + WS_ACT);
            for (int rep = 0; rep < REP_MISC; ++rep) {
            for (int it = gt; it < 256 * 2 * 704; it += NGT) {
                const int j4 = it % 704, rb = it / 704, rr = rb & 1, blk = rb >> 1, j = j4 * 4;
                const bool first = (blk & 127) == 0;
                const int cg_ = 256 * (j >> 7) + 2 * (j & 127);
                f32x4 cvv[2];
                const int pb = first ? blk : blk - 1;
                f32x4 W0[2], W1[2], W2[2], CB[2], C0[2], P3[2], XX[2];
#pragma unroll
                for (int bj = 0; bj < 2; ++bj) {
                    const int ch = bj * DFF + j; const size_t ec = (size_t)cg_ + bj * 4;
                    W0[bj] = *(const f32x4*)(convw + ch); W1[bj] = *(const f32x4*)(convw + NUP + ch); W2[bj] = *(const f32x4*)(convw + 2 * NUP + ch); CB[bj] = *(const f32x4*)(convb + ch);
                    C0[bj] = *(const f32x4*)(edge + ((size_t)blk * 4 + 0) * NUP + ec);
                    P3[bj] = *(const f32x4*)(edge + ((size_t)pb * 4 + 3) * NUP + ec);
                    XX[bj] = *(const f32x4*)(edge + ((rr == 0) ? ((size_t)pb * 4 + 2) : ((size_t)blk * 4 + 1)) * NUP + ec);
                }
#pragma unroll
                for (int bj = 0; bj < 2; ++bj) {
                    const f32x4 zero = (f32x4){0.f, 0.f, 0.f, 0.f};
                    const f32x4 p3 = first ? zero : P3[bj];
                    f32x4 u0, u1, u2;
                    if (rr == 0) { u0 = C0[bj]; u1 = p3; u2 = first ? zero : XX[bj]; }
                    else { u0 = XX[bj]; u1 = C0[bj]; u2 = p3; }
                    cvv[bj] = CB[bj] + W2[bj] * u0 + W1[bj] * u1 + W0[bj] * u2;
                }
                f32x4 o;
#pragma unroll
                for (int e = 0; e < 4; ++e) { const float gt_ = cvv[0][e]; o[e] = gt_ * sigmoidf_(gt_) * cvv[1][e]; }
                u32x2 w; w.x = cvtpk(o[0], o[1]); w.y = cvtpk(o[2], o[3]);
                *(u32x2*)(act + (size_t)(blk * 64 + rr) * DFF + j) = w;
            }
            }
        }
        GRID_SYNC();
        {
            pg8::Gemm g; g.A0 = g.A1 = g.A2 = (const bf16_t*)(ws + WS_ACT); g.B0 = g.B1 = g.B2 = (const bf16_t*)(ws + WS_WDN); g.lda = DFF; g.ldb = DFF; g.K = DFF;
            pg8::Order<T, DM, 1, 0> S; S.init(G, bx);
            for (int rep = 0; rep < REP_G235; ++rep) { EpiResid E{a.out, a.out, (bf16_t*)a.out, stat, (l + 1 < NL) ? 1 : 0, rep == REP_G235 - 1, (const bf16_t*)(ws + WS_X1B), (l + 1 < NL) ? 0 : 1};     pg8::gemm_phase(lds, g, S, E); }
        }
        if (l + 1 < NL) GRID_SYNC();
    }
}

extern "C" void kernel_launch(void* const* d_in, const int* in_sizes, int n_in, void* d_out, int out_size, void* d_ws, size_t ws_size, hipStream_t stream) {
    static int grid = 0;
    if (grid == 0) {
        int dev = 0, cus = 0, per_cu = 0;
        hipGetDevice(&dev);
        hipDeviceGetAttribute(&cus, hipDeviceAttributeMultiprocessorCount, dev);
        hipFuncSetAttribute((const void*)fwd_megakernel, hipFuncAttributeMaxDynamicSharedMemorySize, LDS_BYTES);
        hipOccupancyMaxActiveBlocksPerMultiprocessor(&per_cu, (const void*)fwd_megakernel, 512, LDS_BYTES);
        if (per_cu < 1) { fprintf(stderr, "kernel_launch: occupancy query says %d blocks per CU\n", per_cu); per_cu = 1; }
        (void)hipGetLastError();
        grid = cus * 1;
        if (n_in != 18 || ws_size < 256 * MiB) fprintf(stderr, "kernel_launch: unexpected n_in %d / ws_size %zu\n", n_in, ws_size);
    }
    if (hipMemsetAsync(d_ws, 0, WS_CTL_BYTES, stream) != hipSuccess) { fprintf(stderr, "kernel_launch: memset of the barrier words failed\n"); return; }
    Args a{};
    for (int i = 0; i < 18; ++i) a.in[i] = (const float*)d_in[i];
    a.out = (float*)d_out; a.ws = (unsigned char*)d_ws;
    void* args[] = {&a};
    hipError_t e = hipLaunchCooperativeKernel((const void*)fwd_megakernel, dim3(grid), dim3(512), args, LDS_BYTES, stream);
    if (e != hipSuccess) fprintf(stderr, "cooperative launch failed: %s (grid %d)\n", hipGetErrorString(e), grid);
}
```

```cpp
#include <hip/hip_runtime.h>
#include <hip/hip_cooperative_groups.h>
#include <cstdio>
#include <cstdint>
namespace cg = cooperative_groups;

#define LAS __attribute__((address_space(3)))
typedef unsigned short bf16_t;
typedef short bf16x8 __attribute__((ext_vector_type(8)));
typedef float f32x4 __attribute__((ext_vector_type(4)));
typedef unsigned u32x4 __attribute__((ext_vector_type(4)));
typedef unsigned u32x2 __attribute__((ext_vector_type(2)));
typedef float f32x2_t __attribute__((ext_vector_type(2)));
typedef __bf16 bf16x2_t __attribute__((ext_vector_type(2)));

#ifndef EARLY_EXIT
#define EARLY_EXIT 1
#endif
#define REP_A 1
#define REP_B 1
#define REP_G1 1
#define REP_G4 1
#define REP_SYNC 1
#define REP_MISC 1
#define REP_G235 1
#define GRID_SYNC() do { for (int r_ = 0; r_ < REP_SYNC; ++r_) xcd_barrier(xbar); } while (0)

constexpr int T = 16384, SEQ = 8192, DM = 1024, NIN = 6656, DFF = 2816, NUP = 5632, NL = 2;
constexpr float EPS = 1e-6f;
constexpr size_t MiB = 1u << 20;
constexpr size_t WS_STAT = 1 * MiB;
constexpr size_t WS_WIN = 2 * MiB;
constexpr size_t WS_XB = 15 * MiB;
constexpr size_t WS_OC = 15 * MiB;
constexpr size_t WS_WA = 31 * MiB, WS_WB = 32 * MiB, WS_WC = 33 * MiB, WS_WOUT = 34 * MiB;
constexpr size_t WS_WUP = 36 * MiB;
constexpr size_t WS_UC = 47 * MiB, WS_KA = 63 * MiB, WS_VA = 79 * MiB, WS_KB = 95 * MiB, WS_VB = 111 * MiB, WS_QA = 127 * MiB, WS_QB = 143 * MiB;
constexpr size_t WS_GATES = 159 * MiB;
constexpr size_t WS_WDN = 47 * MiB;
constexpr size_t WS_MERGED = 63 * MiB;
constexpr size_t WS_X1B = 95 * MiB;
constexpr size_t WS_ACT = 127 * MiB;
constexpr size_t WS_EDGE = 215 * MiB;
constexpr int LDS_BYTES = 143360;
constexpr int XB_LDS_OFF = 141312;
constexpr size_t WS_BAR = 16384, WS_CTL_BYTES = 65536;

__device__ __forceinline__ unsigned cvtpk(float lo, float hi) { f32x2_t v = {lo, hi}; bf16x2_t b = __builtin_convertvector(v, bf16x2_t); return __builtin_bit_cast(unsigned, b); }
__device__ __forceinline__ float bf_lo(unsigned w) { return __uint_as_float(w << 16); }
__device__ __forceinline__ float bf_hi(unsigned w) { return __uint_as_float(w & 0xffff0000u); }
__device__ __forceinline__ float rs_of(const float* stat, int row) {
    const f32x4* p = (const f32x4*)(stat + (size_t)row * 16); const f32x4 a = p[0], b = p[1], c = p[2], d = p[3];
    const float s = ((a.x + a.y) + (a.z + a.w)) + ((b.x + b.y) + (b.z + b.w)) + ((c.x + c.y) + (c.z + c.w)) + ((d.x + d.y) + (d.z + d.w));
    return rsqrtf(s * (1.0f / 1024.0f) + EPS);
}
__device__ __forceinline__ size_t plane_off(int blk) {
    return blk == 0 ? WS_QA : blk == 1 ? WS_KA : blk == 2 ? WS_VA : blk == 3 ? WS_QB : blk == 4 ? WS_KB : blk == 5 ? WS_VB : WS_UC;
}

namespace pg8 {
constexpr int BM = 256, BK = 64, HALF = 128, HTB = HALF * BK * 2, STAGE_BYTES = 8 * HTB, NXCD = 8, WGM = 8;
__host__ __device__ __forceinline__ int lds_byte(int r, int c) { const int st = (r >> 4) * 2 + (c >> 5), rr = r & 15, cc = c & 31, ob = rr * 64 + cc * 2; return st * 1024 + (ob ^ (((ob >> 9) & 1) << 5)); }
__host__ __device__ __forceinline__ void stage_rc(int b, int& R, int& C) { const int st = b / 1024, sb = b % 1024, swz = sb ^ (((sb >> 9) & 1) << 5); R = (st >> 1) * 16 + swz / 64; C = (st & 1) * 32 + (swz % 64) / 2; }
__host__ __device__ __forceinline__ int perm32(int rho) { const int n = rho >> 4, i = rho & 15; return 8 * (i >> 2) + 4 * n + (i & 3); }

struct Unit { int pm, pn, br, hf; };
struct Gemm { const bf16_t *A0, *A1, *A2; const bf16_t *B0, *B1, *B2; int lda, ldb, K; };
template <int M_, int N_, int NB, int HALVES> struct Order {
    static constexpr int nM = M_ / BM, nN = N_ / BM, nwg = nM * nN;
    int G, c;
    __device__ __forceinline__ void init(int G_, int c_) { G = G_; c = c_; }
    __device__ __forceinline__ int nfull() const { return nwg / G; }
    __device__ __forceinline__ bool halft() const { const int nf = nwg / G; return HALVES && NB == 1 && nf >= 1 && (nwg - nf * G) * 2 == G; }
    __device__ __forceinline__ bool next(int i, Unit& u) const {
        const int rnd = i / NB; u.br = i - rnd * NB; u.hf = -1;
        int L = rnd * G + c;
        if (HALVES && NB == 1) { const int nf = nwg / G; if ((nwg - nf * G) * 2 == G && nf >= 1) {
            if ((c >> 3) & 1) { if (i == 0) { L = nf * G + (c >> 1); u.hf = c & 1; } else { if (i > nf) return false; L = (i - 1) * G + c; } }
            else if (rnd >= nf) { if (rnd > nf) return false; L = nf * G + (c >> 1); u.hf = c & 1; } } }
        if (L >= nwg) return false;
        int wgid = L; { constexpr int q = nwg / NXCD, r = nwg % NXCD; const int xcd = wgid % NXCD, off = wgid / NXCD; wgid = (xcd < r ? xcd * (q + 1) : r * (q + 1) + (xcd - r) * q) + off; }
        constexpr int nig = WGM * nN; const int gid = wgid / nig, fm = gid * WGM, gsz = (nM - fm) < WGM ? (nM - fm) : WGM;
        u.pm = fm + ((wgid % nig) % gsz); u.pn = (wgid % nig) / gsz; return true;
    }
};

template <class Epi, class Sched>
__device__ __forceinline__ void gemm_phase(LAS unsigned char* lds, const Gemm g, const Sched& S, const Epi& E) {
    int tid = threadIdx.x; asm volatile("" : "+v"(tid));
    const int wid = __builtin_amdgcn_readfirstlane(tid >> 6), lane = tid & 63, wr = wid >> 2, wc = wid & 3, fr = lane & 15, fq = lane >> 4;
    const int nt = g.K / BK;
    unsigned voffA[2], voffB[2];
#pragma unroll
    for (int i = 0; i < 2; ++i) { int R, C; stage_rc(tid * 16 + i * 8192, R, C); const int Rb = (R & ~31) + perm32(R & 31);
        voffA[i] = (unsigned)(R * g.lda + C) * 2u; voffB[i] = (unsigned)(Rb * g.ldb + C) * 2u; }
    const size_t kstep = (size_t)(BK * 2);
    const size_t hstepA = (size_t)HALF * g.lda * 2, tstepA = 2 * hstepA, hstepB = (size_t)HALF * g.ldb * 2, tstepB = 2 * hstepB;
    const unsigned ldsw = (unsigned)wid * 1024u;
    const int aoff = lds_byte(wr * 64 + fr, fq * 8), boff = lds_byte(wc * 32 + fr, fq * 8);
#define PG8_SA(b, h) (((b) * 2 + (h)) * HTB)
#define PG8_SB(b, h) ((4 + (b) * 2 + (h)) * HTB)
#define PG8_STAGE(bufoff, gbase, voff) do { _Pragma("unroll") for (int _i = 0; _i < 2; ++_i) \
        __builtin_amdgcn_global_load_lds((const unsigned*)((const char*)(gbase) + (voff)[_i]), (LAS unsigned*)(lds + (bufoff) + ldsw + _i * 8192), 16, 0, 0); } while (0)
#define PG8_LDA(dst, b, h) do { _Pragma("unroll") for (int m = 0; m < 4; ++m) _Pragma("unroll") for (int k = 0; k < 2; ++k) dst[m][k] = *(const LAS bf16x8*)(lds + PG8_SA(b, h) + aoff + m * 2048 + k * 1024); } while (0)
#define PG8_LDB(dst, b, h) do { _Pragma("unroll") for (int n = 0; n < 2; ++n) _Pragma("unroll") for (int k = 0; k < 2; ++k) dst[n][k] = *(const LAS bf16x8*)(lds + PG8_SB(b, h) + boff + n * 2048 + k * 1024); } while (0)
#define PG8_MMA(ai, bj, At, Bt) do { __builtin_amdgcn_s_setprio(1); _Pragma("unroll") for (int m = 0; m < 4; ++m) _Pragma("unroll") for (int n = 0; n < 2; ++n) _Pragma("unroll") for (int k = 0; k < 2; ++k) \
        acc[ai][bj][m][n] = __builtin_amdgcn_mfma_f32_16x16x32_bf16(Bt[n][k], At[m][k], acc[ai][bj][m][n], 0, 0, 0); __builtin_amdgcn_s_setprio(0); } while (0)
#define PG8_WAIT_V(n) asm volatile("s_waitcnt vmcnt(" #n ")" ::: "memory")
#define PG8_WAIT_L(n) asm volatile("s_waitcnt lgkmcnt(" #n ")" ::: "memory")
#define PG8_BAR __builtin_amdgcn_s_barrier()
#define PG8_SCHED __builtin_amdgcn_sched_barrier(0)
#define PG8_ABASE(u) ((const char*)((u).br == 0 ? g.A0 : ((u).br == 1 ? g.A1 : g.A2)) + (size_t)(u).pm * tstepA)
#define PG8_BBASE(u) ((const char*)((u).br == 0 ? g.B0 : ((u).br == 1 ? g.B1 : g.B2)) + (size_t)(u).pn * tstepB + ((u).hf > 0 ? hstepB : (size_t)0))
    Unit cur, nxt; int ui = 0;
    if (!S.next(0, cur)) return;
    if constexpr (Epi::NEED_RS) {
        LAS float* rst = (LAS float*)(lds + STAGE_BYTES);
        Unit uu;
        for (int i = tid >> 8; S.next(i, uu); i += 2) rst[i * 256 + (tid & 255)] = rs_of(E.stat, uu.pm * 256 + (tid & 255));
        __syncthreads();
    }
    f32x4 acc[2][2][4][2];
#pragma unroll
    for (int a = 0; a < 2; ++a)
#pragma unroll
        for (int b = 0; b < 2; ++b)
#pragma unroll
            for (int m = 0; m < 4; ++m)
#pragma unroll
                for (int n = 0; n < 2; ++n) acc[a][b][m][n] = (f32x4){0.f, 0.f, 0.f, 0.f};
    bf16x8 At[4][2], B0[2][2], B1[2][2];
    const char* cA = PG8_ABASE(cur); const char* cB = PG8_BBASE(cur);
    if (cur.hf >= 0) {
    PG8_STAGE(PG8_SB(0, 0), cB, voffB); PG8_STAGE(PG8_SA(0, 0), cA, voffA); PG8_STAGE(PG8_SA(0, 1), cA + hstepA, voffA);
    if (wr == 1) PG8_BAR;
    PG8_WAIT_V(2); PG8_BAR;
    PG8_STAGE(PG8_SB(1, 0), cB + kstep, voffB); PG8_STAGE(PG8_SA(1, 0), cA + kstep, voffA);
    PG8_WAIT_V(4); PG8_BAR;
    } else {
    PG8_STAGE(PG8_SB(0, 0), cB, voffB); PG8_STAGE(PG8_SB(0, 1), cB + hstepB, voffB); PG8_STAGE(PG8_SA(0, 0), cA, voffA); PG8_STAGE(PG8_SA(0, 1), cA + hstepA, voffA);
    if (wr == 1) PG8_BAR;
    PG8_WAIT_V(2); PG8_BAR;
    PG8_STAGE(PG8_SB(1, 0), cB + kstep, voffB); PG8_STAGE(PG8_SA(1, 0), cA + kstep, voffA); PG8_STAGE(PG8_SB(1, 1), cB + hstepB + kstep, voffB);
    PG8_WAIT_V(6); PG8_BAR;
    }
    for (;;) {
        const bool has_next = S.next(ui + 1, nxt);
        const char* nA = has_next ? PG8_ABASE(nxt) : cA; const char* nB = has_next ? PG8_BBASE(nxt) : cB;
        if (cur.hf >= 0) {
        const int nth = has_next ? nt - 2 : nt;
        for (int t = 0; t < nth; t += 2) {
            const bool last = (t == nt - 2);
            const char* a1 = cA + (size_t)(t + 1) * kstep;
            const char* a2 = last ? nA : cA + (size_t)(t + 2) * kstep; const char* b2 = last ? nB : cB + (size_t)(t + 2) * kstep;
            const char* a3 = a2 + kstep; const char* b3 = b2 + kstep;
            PG8_LDB(B0, 0, 0); PG8_SCHED; PG8_LDA(At, 0, 0); PG8_STAGE(PG8_SA(1, 1), a1 + hstepA, voffA);
            PG8_WAIT_V(6); PG8_WAIT_L(0); PG8_BAR; PG8_MMA(0, 0, At, B0); PG8_BAR; PG8_SCHED;
            PG8_LDA(At, 0, 1); PG8_STAGE(PG8_SB(0, 0), b2, voffB); PG8_STAGE(PG8_SA(0, 0), a2, voffA);
            PG8_WAIT_V(6); PG8_WAIT_L(0); PG8_BAR; PG8_MMA(1, 0, At, B0); PG8_BAR; PG8_SCHED;
            PG8_LDB(B0, 1, 0); PG8_SCHED; PG8_LDA(At, 1, 0); PG8_STAGE(PG8_SA(0, 1), a2 + hstepA, voffA);
            PG8_WAIT_V(6); PG8_WAIT_L(0); PG8_BAR; PG8_MMA(0, 0, At, B0); PG8_BAR; PG8_SCHED;
            PG8_LDA(At, 1, 1); PG8_STAGE(PG8_SB(1, 0), b3, voffB); PG8_STAGE(PG8_SA(1, 0), a3, voffA);
            PG8_WAIT_V(6); PG8_WAIT_L(0); PG8_BAR; PG8_MMA(1, 0, At, B0); PG8_BAR; PG8_SCHED;
        }
        if (has_next) {
            const char* a1 = cA + (size_t)(nt - 1) * kstep;
            const char* a2 = nA; const char* b2 = nB; const char* a3 = a2 + kstep; const char* b3 = b2 + kstep;
            PG8_LDB(B0, 0, 0); PG8_SCHED; PG8_LDA(At, 0, 0); PG8_STAGE(PG8_SA(1, 1), a1 + hstepA, voffA);
            PG8_WAIT_V(6); PG8_WAIT_L(0); PG8_BAR; PG8_MMA(0, 0, At, B0); PG8_BAR; PG8_SCHED;
            PG8_LDA(At, 0, 1); PG8_STAGE(PG8_SB(0, 0), b2, voffB); PG8_STAGE(PG8_SB(0, 1), b2 + hstepB, voffB); PG8_STAGE(PG8_SA(0, 0), a2, voffA);
            PG8_WAIT_V(8); PG8_WAIT_L(0); PG8_BAR; PG8_MMA(1, 0, At, B0); PG8_BAR; PG8_SCHED;
            PG8_LDB(B0, 1, 0); PG8_SCHED; PG8_LDA(At, 1, 0); PG8_STAGE(PG8_SA(0, 1), a2 + hstepA, voffA);
            PG8_WAIT_V(8); PG8_WAIT_L(0); PG8_BAR; PG8_MMA(0, 0, At, B0); PG8_BAR; PG8_SCHED;
            PG8_LDA(At, 1, 1); PG8_STAGE(PG8_SB(1, 0), b3, voffB); PG8_STAGE(PG8_SB(1, 1), b3 + hstepB, voffB); PG8_STAGE(PG8_SA(1, 0), a3, voffA);
            PG8_WAIT_V(8); PG8_WAIT_L(0); PG8_BAR; PG8_MMA(1, 0, At, B0); PG8_BAR; PG8_SCHED;
        }
        } else
        for (int t = 0; t < nt; t += 2) {
            const bool last = (t == nt - 2);
            const char* a1 = cA + (size_t)(t + 1) * kstep;
            const char* a2 = last ? nA : cA + (size_t)(t + 2) * kstep; const char* b2 = last ? nB : cB + (size_t)(t + 2) * kstep;
            const char* a3 = a2 + kstep; const char* b3 = b2 + kstep;
            PG8_LDB(B0, 0, 0); PG8_LDB(B1, 0, 1); PG8_SCHED; PG8_LDA(At, 0, 0); PG8_STAGE(PG8_SA(1, 1), a1 + hstepA, voffA);
            PG8_WAIT_V(8); PG8_WAIT_L(0); PG8_BAR; PG8_MMA(0, 0, At, B0); PG8_MMA(0, 1, At, B1); PG8_BAR; PG8_SCHED;
            PG8_LDA(At, 0, 1); PG8_STAGE(PG8_SB(0, 0), b2, voffB); PG8_STAGE(PG8_SB(0, 1), b2 + hstepB, voffB); PG8_STAGE(PG8_SA(0, 0), a2, voffA);
            PG8_WAIT_V(8); PG8_WAIT_L(0); PG8_BAR; PG8_MMA(1, 0, At, B0); PG8_MMA(1, 1, At, B1); PG8_BAR; PG8_SCHED;
            PG8_LDB(B0, 1, 0); PG8_LDB(B1, 1, 1); PG8_SCHED; PG8_LDA(At, 1, 0); PG8_STAGE(PG8_SA(0, 1), a2 + hstepA, voffA);
            PG8_WAIT_V(8); PG8_WAIT_L(0); PG8_BAR; PG8_MMA(0, 0, At, B0); PG8_MMA(0, 1, At, B1); PG8_BAR; PG8_SCHED;
            PG8_LDA(At, 1, 1); PG8_STAGE(PG8_SB(1, 0), b3, voffB); PG8_STAGE(PG8_SB(1, 1), b3 + hstepB, voffB); PG8_STAGE(PG8_SA(1, 0), a3, voffA);
            PG8_WAIT_V(8); PG8_WAIT_L(0); PG8_BAR; PG8_MMA(1, 0, At, B0); PG8_MMA(1, 1, At, B1); PG8_BAR; PG8_SCHED;
        }
        if (wr == 0) PG8_BAR;
        E(acc, cur, wr, wc, fr, fq, (const LAS float*)(lds + STAGE_BYTES) + ui * 256);
        if (!has_next) break;
        if (E.zero_after(cur)) {
#pragma unroll
            for (int a = 0; a < 2; ++a)
#pragma unroll
                for (int b = 0; b < 2; ++b)
#pragma unroll
                    for (int m = 0; m < 4; ++m)
#pragma unroll
                        for (int n = 0; n < 2; ++n) acc[a][b][m][n] = (f32x4){0.f, 0.f, 0.f, 0.f};
        }
        cur = nxt; cA = nA; cB = nB; ++ui;
        if (wr == 1) PG8_BAR;
    }
    PG8_WAIT_V(0);
    PG8_BAR;
#undef PG8_SA
#undef PG8_SB
#undef PG8_STAGE
#undef PG8_LDA
#undef PG8_LDB
#undef PG8_MMA
#undef PG8_WAIT_V
#undef PG8_WAIT_L
#undef PG8_BAR
#undef PG8_SCHED
#undef PG8_ABASE
#undef PG8_BBASE
}
}

struct Pair2 { float lo, hi; };
__device__ __forceinline__ Pair2 row_pair16(float m) { auto r = __builtin_amdgcn_permlane16_swap(__float_as_uint(m), __float_as_uint(m), false, false); return Pair2{__uint_as_float(r[0]), __uint_as_float(r[1])}; }
__device__ __forceinline__ Pair2 half_pair32(float m) { auto r = __builtin_amdgcn_permlane32_swap(__float_as_uint(m), __float_as_uint(m), false, false); return Pair2{__uint_as_float(r[0]), __uint_as_float(r[1])}; }
__device__ __forceinline__ float quads_sum(float v) { const Pair2 a = row_pair16(v); const Pair2 b = half_pair32(a.lo + a.hi); return b.lo + b.hi; }
__device__ __forceinline__ float quads_max(float v) { const Pair2 a = row_pair16(v); const Pair2 b = half_pair32(fmaxf(a.lo, a.hi)); return fmaxf(b.lo, b.hi); }
template <int CTRL> __device__ __forceinline__ float dpp_f(float v) { return __builtin_bit_cast(float, __builtin_amdgcn_update_dpp(0, __builtin_bit_cast(int, v), CTRL, 0xF, 0xF, false)); }
__device__ __forceinline__ float oct_sum(float v) { v += dpp_f<0xB1>(v); v += dpp_f<0x4E>(v); v += dpp_f<0x141>(v); return v; }
typedef f32x4 (&AccRef)[2][2][4][2];
__device__ __forceinline__ float sigmoidf_(float x) { return __builtin_amdgcn_rcpf(1.0f + __expf(-x)); }

struct EpiProj {
    static constexpr bool NEED_RS = true;
    unsigned char* ws; const float* stat; const float* bgate;
    __device__ __forceinline__ bool zero_after(const pg8::Unit&) const { return true; }
    __device__ __forceinline__ void operator()(AccRef acc, const pg8::Unit& u, int wr, int wc, int fr, int fq, const LAS float* rst) const {
        const int row0 = u.pm * 256 + wr * 64 + fr;
        const int nbj = (u.hf >= 0) ? 1 : 2, hofs = (u.hf > 0) ? 128 : 0;
        if (u.pn < 14) {
            bf16_t* base = (bf16_t*)(ws + plane_off(u.pn >> 1)); const int col0 = (u.pn & 1) * 256 + hofs + wc * 32 + 8 * fq;
#pragma unroll
            for (int ai = 0; ai < 2; ++ai)
#pragma unroll
                for (int m = 0; m < 4; ++m) { const int row = row0 + ai * 128 + m * 16; const float rs = rst[wr * 64 + fr + ai * 128 + m * 16]; bf16_t* rowp = base + (size_t)row * 512 + col0;
#pragma unroll
                    for (int bj = 0; bj < 2; ++bj) if (bj < nbj) { const f32x4 v0 = acc[ai][bj][m][0] * rs, v1 = acc[ai][bj][m][1] * rs;
                        u32x4 w; w.x = cvtpk(v0[0], v0[1]); w.y = cvtpk(v0[2], v0[3]); w.z = cvtpk(v1[0], v1[1]); w.w = cvtpk(v1[2], v1[3]);
                        *(u32x4*)(rowp + bj * 128) = w; } }
        } else {
            bf16_t* base = (bf16_t*)(ws + WS_GATES); const int col0 = (u.pn - 14) * 256 + hofs + wc * 32 + 8 * fq;
            f32x4 bv[2][2];
#pragma unroll
            for (int bj = 0; bj < 2; ++bj)
#pragma unroll
                for (int n = 0; n < 2; ++n) bv[bj][n] = *(const f32x4*)(bgate + col0 + bj * 128 + 4 * n);
#pragma unroll
            for (int ai = 0; ai < 2; ++ai)
#pragma unroll
                for (int m = 0; m < 4; ++m) { const int row = row0 + ai * 128 + m * 16; const float rs = rst[wr * 64 + fr + ai * 128 + m * 16]; bf16_t* rowp = base + (size_t)row * 3072 + col0;
#pragma unroll
                    for (int bj = 0; bj < 2; ++bj) if (bj < nbj) { f32x4 v0 = acc[ai][bj][m][0] * rs + bv[bj][0], v1 = acc[ai][bj][m][1] * rs + bv[bj][1];
#pragma unroll
                        for (int e = 0; e < 4; ++e) { v0[e] = fmaxf(sigmoidf_(v0[e]), 8.7e-19f); v1[e] = fmaxf(sigmoidf_(v1[e]), 8.7e-19f); }
                        u32x4 w; w.x = cvtpk(v0[0], v0[1]); w.y = cvtpk(v0[2], v0[3]); w.z = cvtpk(v1[0], v1[1]); w.w = cvtpk(v1[2], v1[3]);
                        *(u32x4*)(rowp + bj * 128) = w; } }
        }
    }
};

struct EpiBranch {
    static constexpr bool NEED_RS = false;
    const bf16_t* gates; bf16_t* merged;
    __device__ __forceinline__ bool zero_after(const pg8::Unit& u) const { return u.br == 2; }
    __device__ __forceinline__ void operator()(AccRef acc, const pg8::Unit& u, int wr, int wc, int fr, int fq, const LAS float* rst) const {
        const int row0 = u.pm * 256 + wr * 64 + fr, col0 = u.pn * 256 + wc * 32 + 8 * fq;
#define RCP_(x) __builtin_amdgcn_rcpf(x)
#pragma unroll
        for (int ai = 0; ai < 2; ++ai) {
            if (u.br < 2) {
                u32x4 ga[4][2], gb[4][2];
#pragma unroll
                for (int m = 0; m < 4; ++m)
#pragma unroll
                    for (int bj = 0; bj < 2; ++bj) { const bf16_t* gp = gates + (size_t)(row0 + ai * 128 + m * 16) * 3072 + col0 + bj * 128;
                        ga[m][bj] = *(const u32x4*)(gp + u.br * 1024); gb[m][bj] = *(const u32x4*)(gp + (u.br + 1) * 1024); }
#pragma unroll
                for (int m = 0; m < 4; ++m)
#pragma unroll
                    for (int bj = 0; bj < 2; ++bj) { const u32x4 a = ga[m][bj], b = gb[m][bj];
                        f32x4 r0, r1;
                        r0[0] = bf_lo(a.x) * RCP_(bf_lo(b.x)); r0[1] = bf_hi(a.x) * RCP_(bf_hi(b.x)); r0[2] = bf_lo(a.y) * RCP_(bf_lo(b.y)); r0[3] = bf_hi(a.y) * RCP_(bf_hi(b.y));
                        r1[0] = bf_lo(a.z) * RCP_(bf_lo(b.z)); r1[1] = bf_hi(a.z) * RCP_(bf_hi(b.z)); r1[2] = bf_lo(a.w) * RCP_(bf_lo(b.w)); r1[3] = bf_hi(a.w) * RCP_(bf_hi(b.w));
                        acc[ai][bj][m][0] *= r0; acc[ai][bj][m][1] *= r1; }
            } else {
                u32x4 gc[4][2];
#pragma unroll
                for (int m = 0; m < 4; ++m)
#pragma unroll
                    for (int bj = 0; bj < 2; ++bj) gc[m][bj] = *(const u32x4*)(gates + (size_t)(row0 + ai * 128 + m * 16) * 3072 + col0 + bj * 128 + 2048);
#pragma unroll
                for (int m = 0; m < 4; ++m)
#pragma unroll
                    for (int bj = 0; bj < 2; ++bj) { const u32x4 a = gc[m][bj]; const int row = row0 + ai * 128 + m * 16;
                        f32x4 g0, g1; g0[0] = bf_lo(a.x); g0[1] = bf_hi(a.x); g0[2] = bf_lo(a.y); g0[3] = bf_hi(a.y); g1[0] = bf_lo(a.z); g1[1] = bf_hi(a.z); g1[2] = bf_lo(a.w); g1[3] = bf_hi(a.w);
                        const f32x4 v0 = acc[ai][bj][m][0] * g0, v1 = acc[ai][bj][m][1] * g1;
                        u32x4 w; w.x = cvtpk(v0[0], v0[1]); w.y = cvtpk(v0[2], v0[3]); w.z = cvtpk(v1[0], v1[1]); w.w = cvtpk(v1[2], v1[3]);
                        *(u32x4*)(merged + (size_t)row * 1024 + col0 + bj * 128) = w; }
            }
        }
#undef RCP_
    }
};

struct EpiResid {
    static constexpr bool NEED_RS = false;
    const float* base; float* out; bf16_t* xb; float* stat; int extras; int store;
    const bf16_t* base16; int f32out;
    __device__ __forceinline__ bool zero_after(const pg8::Unit&) const { return true; }
    __device__ __forceinline__ void operator()(AccRef acc, const pg8::Unit& u, int wr, int wc, int fr, int fq, const LAS float* rst) const {
        const int row0 = u.pm * 256 + wr * 64 + fr, col0 = u.pn * 256 + wc * 32 + 8 * fq;
#pragma unroll
        for (int ai = 0; ai < 2; ++ai) {
            f32x4 B0[4][2], B1[4][2];
            if (base16) {
                u32x4 bw[4][2];
#pragma unroll
                for (int m = 0; m < 4; ++m)
#pragma unroll
                    for (int bj = 0; bj < 2; ++bj) bw[m][bj] = *(const u32x4*)(base16 + (size_t)(row0 + ai * 128 + m * 16) * 1024 + col0 + bj * 128);
#pragma unroll
                for (int m = 0; m < 4; ++m)
#pragma unroll
                    for (int bj = 0; bj < 2; ++bj) { const u32x4 w_ = bw[m][bj]; B0[m][bj] = (f32x4){bf_lo(w_.x), bf_hi(w_.x), bf_lo(w_.y), bf_hi(w_.y)}; B1[m][bj] = (f32x4){bf_lo(w_.z), bf_hi(w_.z), bf_lo(w_.w), bf_hi(w_.w)}; }
            } else {
#pragma unroll
                for (int m = 0; m < 4; ++m)
#pragma unroll
                    for (int bj = 0; bj < 2; ++bj) { const size_t off = (size_t)(row0 + ai * 128 + m * 16) * 1024 + col0 + bj * 128; B0[m][bj] = *(const f32x4*)(base + off); B1[m][bj] = *(const f32x4*)(base + off + 4); }
            }
#pragma unroll
            for (int m = 0; m < 4; ++m) { const int row = row0 + ai * 128 + m * 16; float ss = 0.f;
#pragma unroll
                for (int bj = 0; bj < 2; ++bj) { const size_t off = (size_t)row * 1024 + col0 + bj * 128;
                    const f32x4 o0 = B0[m][bj] + acc[ai][bj][m][0], o1 = B1[m][bj] + acc[ai][bj][m][1];
                    if (store && f32out) { *(f32x4*)(out + off) = o0; *(f32x4*)(out + off + 4) = o1; }
                    if (extras && store) { u32x4 w; w.x = cvtpk(o0[0], o0[1]); w.y = cvtpk(o0[2], o0[3]); w.z = cvtpk(o1[0], o1[1]); w.w = cvtpk(o1[2], o1[3]); *(u32x4*)(xb + off) = w; }
                    ss += (o0[0] * o0[0] + o0[1] * o0[1]) + (o0[2] * o0[2] + o0[3] * o0[3]) + (o1[0] * o1[0] + o1[1] * o1[1]) + (o1[2] * o1[2] + o1[3] * o1[3]); }
                ss = quads_sum(ss);
                if (extras && store && fq == 0) stat[(size_t)row * 16 + u.pn * 4 + wc] = ss; }
        }
    }
};

template <int N> __device__ __forceinline__ float dpp_ror(float v) {
    return __builtin_bit_cast(float, __builtin_amdgcn_update_dpp(0, __builtin_bit_cast(int, v), 0x120 + N, 0xF, 0xF, false));
}
struct EpiUp {
    static constexpr bool NEED_RS = true;
    const float* stat; const float* convw; const float* convb; bf16_t* act; float* edge;
    __device__ __forceinline__ bool zero_after(const pg8::Unit&) const { return true; }
    __device__ __forceinline__ void operator()(AccRef acc, const pg8::Unit& u, int wr, int wc, int fr, int fq, const LAS float* rst) const {
        const int row0 = u.pm * 256 + wr * 64 + fr;
        const int nbj = (u.hf >= 0) ? 1 : 2, hb = (u.hf > 0) ? 1 : 0;
#pragma unroll
        for (int bj = 0; bj < 2; ++bj) if (bj < nbj) {
            const int j = u.pn * 128 + (bj + hb) * 64 + wc * 16 + 4 * fq;
            const f32x4 g0 = *(const f32x4*)(convw + j), g1 = *(const f32x4*)(convw + NUP + j), g2 = *(const f32x4*)(convw + 2 * NUP + j), gb = *(const f32x4*)(convb + j);
            const f32x4 v0 = *(const f32x4*)(convw + DFF + j), v1 = *(const f32x4*)(convw + NUP + DFF + j), v2 = *(const f32x4*)(convw + 2 * NUP + DFF + j), vb = *(const f32x4*)(convb + DFF + j);
            const size_t ecol = (size_t)u.pn * 256 + (bj + hb) * 128 + wc * 32 + 8 * fq;
#pragma unroll
            for (int ai = 0; ai < 2; ++ai) {
                const int blk = u.pm * 4 + ai * 2 + wr;
                f32x4 pg1, pg2, pv1, pv2;
                pg1 = pg2 = pv1 = pv2 = (f32x4){0.f, 0.f, 0.f, 0.f};
#pragma unroll
                for (int m = 0; m < 4; ++m) {
                    const int row = row0 + ai * 128 + m * 16;
                    const float rs = rst[wr * 64 + fr + ai * 128 + m * 16];
                    const f32x4 ug = acc[ai][bj][m][0] * rs, uv = acc[ai][bj][m][1] * rs;
                    f32x4 rg1, rg2, rv1, rv2;
#pragma unroll
                    for (int e = 0; e < 4; ++e) { rg1[e] = dpp_ror<1>(ug[e]); rg2[e] = dpp_ror<2>(ug[e]); rv1[e] = dpp_ror<1>(uv[e]); rv2[e] = dpp_ror<2>(uv[e]); }
                    if (m == 0 && fr < 2) { *(f32x4*)(edge + ((size_t)blk * 4 + fr) * NUP + ecol) = ug; *(f32x4*)(edge + ((size_t)blk * 4 + fr) * NUP + ecol + 4) = uv; }
                    if (m == 3 && fr >= 14) { *(f32x4*)(edge + ((size_t)blk * 4 + (fr - 12)) * NUP + ecol) = ug; *(f32x4*)(edge + ((size_t)blk * 4 + (fr - 12)) * NUP + ecol + 4) = uv; }
                    const f32x4 qg1 = (fr >= 1) ? rg1 : pg1, qg2 = (fr >= 2) ? rg2 : pg2, qv1 = (fr >= 1) ? rv1 : pv1, qv2 = (fr >= 2) ? rv2 : pv2;
                    const f32x4 cg = gb + g2 * ug + g1 * qg1 + g0 * qg2, cv = vb + v2 * uv + v1 * qv1 + v0 * qv2;
                    if (!(m == 0 && fr < 2)) {
                        f32x4 o;
#pragma unroll
                        for (int e = 0; e < 4; ++e) o[e] = cg[e] * sigmoidf_(cg[e]) * cv[e];
                        u32x2 w; w.x = cvtpk(o[0], o[1]); w.y = cvtpk(o[2], o[3]);
                        *(u32x2*)(act + (size_t)row * DFF + j) = w;
                    }
                    pg1 = rg1; pg2 = rg2; pv1 = rv1; pv2 = rv2;
                }
            }
        }
    }
};

__device__ __forceinline__ void transpose_item(const float* W, int K, int N, bf16_t* WT, int item, int lane, LAS float* scr, const float* gain, int mode) {
    const int nblk = N / 32, kb = item / nblk, nb = item % nblk, k0 = 64 * kb, n0 = 32 * nb;
    {
        f32x4 v[8]; float gnv[8];
#pragma unroll
        for (int i = 0; i < 8; ++i) v[i] = *(const f32x4*)(W + (size_t)(k0 + (lane >> 3) + 8 * i) * N + n0 + 4 * (lane & 7));
#pragma unroll
        for (int i = 0; i < 8; ++i) gnv[i] = gain ? gain[k0 + (lane >> 3) + 8 * i] : 1.0f;
#pragma unroll
        for (int i = 0; i < 8; ++i) { const int kk = (lane >> 3) + 8 * i; const float gn = gnv[i]; LAS float* d = scr + kk * 33 + 4 * (lane & 7);
            d[0] = v[i].x * gn; d[1] = v[i].y * gn; d[2] = v[i].z * gn; d[3] = v[i].w * gn; }
    }
    asm volatile("s_waitcnt lgkmcnt(0)" ::: "memory");
    int drow0 = n0;
    if (mode == 1) { const int j0 = (n0 < DFF) ? n0 : n0 - DFF; drow0 = 256 * (j0 >> 7) + 2 * (j0 & 127) + ((n0 < DFF) ? 0 : 4); }
    const int c = lane & 7;
#pragma unroll
    for (int jj = 0; jj < 4; ++jj) { const int n = (lane >> 3) + 8 * jj; const LAS float* s = scr + (8 * c) * 33 + n;
        u32x4 o; o.x = cvtpk(s[0 * 33], s[1 * 33]); o.y = cvtpk(s[2 * 33], s[3 * 33]); o.z = cvtpk(s[4 * 33], s[5 * 33]); o.w = cvtpk(s[6 * 33], s[7 * 33]);
        *(u32x4*)(WT + (size_t)(drow0 + (mode == 1 ? 8 * (n >> 2) + (n & 3) : n)) * K + k0 + 8 * c) = o; }
    asm volatile("s_waitcnt lgkmcnt(0)" ::: "memory");
}
__device__ __forceinline__ void convert_weight(const float* W, int K, int N, bf16_t* WT, const float* gain, int mode, LAS unsigned char* lds, int wave, int lane, int gw, int NGW) {
    LAS float* scr = (LAS float*)(lds + wave * 8448);
    const int nitems = (K / 64) * (N / 32);
    for (int it = gw; it < nitems; it += NGW) transpose_item(W, K, N, WT, it, lane, scr, gain, mode);
}
__device__ __forceinline__ float wave_sum(float v) {
#pragma unroll
    for (int o = 1; o < 64; o <<= 1) v += __shfl_xor(v, o);
    return v;
}

#define MFMA16(a, b, c) __builtin_amdgcn_mfma_f32_16x16x32_bf16((a), (b), (c), 0, 0, 0)
__device__ __forceinline__ void unpack8(const u32x4 w, float (&f)[8]) { f[0] = bf_lo(w.x); f[1] = bf_hi(w.x); f[2] = bf_lo(w.y); f[3] = bf_hi(w.y); f[4] = bf_lo(w.z); f[5] = bf_hi(w.z); f[6] = bf_lo(w.w); f[7] = bf_hi(w.w); }
__device__ __forceinline__ u32x4 pack8(const float (&f)[8]) { u32x4 w; w.x = cvtpk(f[0], f[1]); w.y = cvtpk(f[2], f[3]); w.z = cvtpk(f[4], f[5]); w.w = cvtpk(f[6], f[7]); return w; }

template <int WIN> __device__ __forceinline__ void pool_rows(const bf16_t* UC, bf16_t* OC, int t, int cofs) {
    const int pos = t & (SEQ - 1);
    u32x4 v[WIN];
#pragma unroll
    for (int i = 0; i < WIN; ++i) { const bool ok = i <= pos; v[i] = *(const u32x4*)(UC + (size_t)(ok ? t - i : t) * 512 + cofs); }
    float cur[8], sum[8]; unpack8(v[0], cur);
#pragma unroll
    for (int e = 0; e < 8; ++e) sum[e] = cur[e];
#pragma unroll
    for (int i = 1; i < WIN; ++i) { float f[8]; unpack8(v[i], f); const float wgt = (i <= pos) ? 1.f : 0.f;
#pragma unroll
        for (int e = 0; e < 8; ++e) sum[e] += wgt * f[e]; }
    const int n = (pos + 1 < WIN) ? pos + 1 : WIN; const float invn = 1.0f / (float)n;
#pragma unroll
    for (int e = 0; e < 8; ++e) sum[e] = sum[e] * invn - cur[e];
    *(u32x4*)(OC + (size_t)t * 512 + cofs) = pack8(sum);
}

constexpr int A_KS = 0, A_KSTRIDE = 528, A_VT = 67584, A_VSTRIDE = 528, A_RB = 135168, A_BUF = 33792;
typedef short v4i16_t __attribute__((ext_vector_type(4)));
__device__ __forceinline__ v4i16_t lds_tr16(const LAS unsigned char* p) { return __builtin_amdgcn_ds_read_tr16_b64_v4i16((LAS v4i16_t*)p); }
template <int WIN> __device__ __forceinline__ void pool_rows2(const bf16_t* UC, bf16_t* OC, int ta, int tb, int cofs) {
    const int posa = ta & (SEQ - 1), posb = tb & (SEQ - 1);
    u32x4 va[WIN], vb[WIN];
#pragma unroll
    for (int i = 0; i < WIN; ++i) { va[i] = *(const u32x4*)(UC + (size_t)((i <= posa) ? ta - i : ta) * 512 + cofs); }
#pragma unroll
    for (int i = 0; i < WIN; ++i) { vb[i] = *(const u32x4*)(UC + (size_t)((i <= posb) ? tb - i : tb) * 512 + cofs); }
#pragma unroll
    for (int h = 0; h < 2; ++h) {
        const int pos = h ? posb : posa, t = h ? tb : ta;
        float cur[8], sum[8]; unpack8(h ? vb[0] : va[0], cur);
#pragma unroll
        for (int e = 0; e < 8; ++e) sum[e] = cur[e];
#pragma unroll
        for (int i = 1; i < WIN; ++i) { float f[8]; unpack8(h ? vb[i] : va[i], f); const float wgt = (i <= pos) ? 1.f : 0.f;
#pragma unroll
            for (int e = 0; e < 8; ++e) sum[e] += wgt * f[e]; }
        const int n = (pos + 1 < WIN) ? pos + 1 : WIN; const float invn = 1.0f / (float)n;
#pragma unroll
        for (int e = 0; e < 8; ++e) sum[e] = sum[e] * invn - cur[e];
        *(u32x4*)(OC + (size_t)t * 512 + cofs) = pack8(sum);
    }
}
__device__ __forceinline__ void sm_chain(f32x4 (&s)[4], int j, int qi, int quad, const LAS float* rbh, float& m_run, float& l_run, f32x4 (&O)[4], bf16x8 (&pb)[2]) {
    if (j >= 6) {
        const int dbase = qi + 64 * (8 - j) + 63;
#pragma unroll
        for (int t = 0; t < 4; ++t)
#pragma unroll
            for (int e = 0; e < 4; ++e) { const int ki = 16 * t + 4 * quad + e; int idx = dbase - ki; idx = idx > 191 ? 191 : idx; s[t][e] += rbh[idx]; }
    }
    float mx = fmaxf(fmaxf(s[0][0], s[0][1]), fmaxf(s[0][2], s[0][3]));
#pragma unroll
    for (int t = 1; t < 4; ++t) mx = fmaxf(mx, fmaxf(fmaxf(s[t][0], s[t][1]), fmaxf(s[t][2], s[t][3])));
    mx = quads_max(mx);
    const float m_new = fmaxf(m_run, mx), alpha = __builtin_amdgcn_exp2f(m_run - m_new);
    float ps = 0.f;
#pragma unroll
    for (int t = 0; t < 4; ++t)
#pragma unroll
        for (int e = 0; e < 4; ++e) { s[t][e] = __builtin_amdgcn_exp2f(s[t][e] - m_new); ps += s[t][e]; }
    l_run = l_run * alpha + ps; m_run = m_new;
    if (__any(alpha != 1.0f)) {
#pragma unroll
        for (int d = 0; d < 4; ++d) O[d] *= alpha;
    }
#pragma unroll
    for (int s2 = 0; s2 < 2; ++s2) { u32x4 w; w.x = cvtpk(s[2 * s2][0], s[2 * s2][1]); w.y = cvtpk(s[2 * s2][2], s[2 * s2][3]); w.z = cvtpk(s[2 * s2 + 1][0], s[2 * s2 + 1][1]); w.w = cvtpk(s[2 * s2 + 1][2], s[2 * s2 + 1][3]); pb[s2] = __builtin_bit_cast(bf16x8, w); }
}
__device__ __forceinline__ void attnA_unit(int b, int c, int hq, unsigned char* ws, const float* gq, const float* gk, const float* rb, LAS unsigned char* L, int store) {
    int tid = threadIdx.x; asm volatile("" : "+v"(tid));
    const int lane = tid & 63, wid = __builtin_amdgcn_readfirstlane(tid >> 6), hl = wid >> 1, qp = wid & 1, fr = lane & 15, quad = lane >> 4;
    const int h = hq * 4 + hl;
    bf16_t* QA = (bf16_t*)(ws + WS_QA); const bf16_t* KA = (const bf16_t*)(ws + WS_KA); const bf16_t* VA = (const bf16_t*)(ws + WS_VA);
    const int R0 = b * SEQ + c * 64;
    const int qrow = R0 + qp * 32 + fr;
    const int jlo = (c >= 8) ? 0 : 8 - c;
    u32x4 kreg[4], vreg[4];
    const int srow0 = tid >> 5, sch = tid & 31;
#define A_FETCH(jj) do { const size_t rk_ = (size_t)(b * SEQ + (c + (jj) - 8) * 64); _Pragma("unroll") for (int i = 0; i < 4; ++i) { \
        const size_t off_ = (rk_ + srow0 + 16 * i) * 512 + hq * 256 + sch * 8; kreg[i] = *(const u32x4*)(KA + off_); vreg[i] = *(const u32x4*)(VA + off_); } } while (0)
#define A_STAGE(bufo) do { _Pragma("unroll") for (int i = 0; i < 4; ++i) { const int row_ = srow0 + 16 * i; float f_[8]; unpack8(kreg[i], f_); float ss_ = 0.f; \
        _Pragma("unroll") for (int e = 0; e < 8; ++e) ss_ += f_[e] * f_[e]; \
        ss_ = oct_sum(ss_); const float rs_ = rsqrtf(ss_ * (1.0f / 64.0f) + EPS); \
        _Pragma("unroll") for (int e = 0; e < 8; ++e) f_[e] *= rs_; \
        *(LAS u32x4*)(L + A_KS + (bufo) + row_ * A_KSTRIDE + sch * 16) = pack8(f_); \
        *(LAS u32x4*)(L + A_VT + (bufo) + row_ * A_VSTRIDE + sch * 16) = vreg[i]; } } while (0)
    A_FETCH(jlo);
    LAS float* rbs = (LAS float*)(L + A_RB);
    const float rb_a = rb[(hq * 4) * 192 + tid], rb_b = (tid < 256) ? rb[(hq * 4) * 192 + 512 + tid] : 0.f;
    bf16x8 qf[2][2];
#pragma unroll
    for (int i = 0; i < 2; ++i) {
        const bf16_t* qptr = QA + (size_t)(qrow + 16 * i) * 512 + h * 64 + quad * 8;
        const u32x4 w0 = *(const u32x4*)qptr, w1 = *(const u32x4*)(qptr + 32);
        float f0[8], f1[8]; unpack8(w0, f0); unpack8(w1, f1);
        float ss = 0.f;
#pragma unroll
        for (int e = 0; e < 8; ++e) ss += f0[e] * f0[e] + f1[e] * f1[e];
        ss = quads_sum(ss);
        const float rs = rsqrtf(ss * (1.0f / 64.0f) + EPS) * (0.125f * 1.4426950408889634f);
#pragma unroll
        for (int e = 0; e < 8; ++e) { f0[e] *= rs * gq[quad * 8 + e] * gk[quad * 8 + e]; f1[e] *= rs * gq[32 + quad * 8 + e] * gk[32 + quad * 8 + e]; }
        qf[i][0] = __builtin_bit_cast(bf16x8, pack8(f0)); qf[i][1] = __builtin_bit_cast(bf16x8, pack8(f1));
    }
    rbs[tid] = rb_a * 1.4426950408889634f; if (tid < 256) rbs[512 + tid] = rb_b * 1.4426950408889634f;
    A_STAGE(0);
    if (jlo < 8) A_FETCH(jlo + 1);
    float m0 = -1e30f, m1 = -1e30f, l0 = 0.f, l1 = 0.f;
    f32x4 O0[4], O1[4];
#pragma unroll
    for (int d = 0; d < 4; ++d) { O0[d] = (f32x4){0.f, 0.f, 0.f, 0.f}; O1[d] = (f32x4){0.f, 0.f, 0.f, 0.f}; }
    __syncthreads();
    for (int j = jlo; j <= 8; ++j) {
        const int bufo = ((j - jlo) & 1) * A_BUF;
        if (j < 8) { A_STAGE(A_BUF - bufo); if (j < 7) A_FETCH(j + 2); }
        f32x4 s0[4], s1[4];
        const LAS float* rbh = rbs + hl * 192;
        const float bc0 = (j >= 6) ? 0.f : rbh[191];
#pragma unroll
        for (int t = 0; t < 4; ++t) {
            f32x4 a0 = (f32x4){bc0, bc0, bc0, bc0}, a1 = a0;
#pragma unroll
            for (int ks = 0; ks < 2; ++ks) { const bf16x8 kf = *(const LAS bf16x8*)(L + A_KS + bufo + (16 * t + fr) * A_KSTRIDE + hl * 128 + ks * 64 + quad * 16); a0 = MFMA16(kf, qf[0][ks], a0); a1 = MFMA16(kf, qf[1][ks], a1); }
            s0[t] = a0; s1[t] = a1;
        }
        bf16x8 pb0[2], pb1[2];
        sm_chain(s0, j, qp * 32 + fr, quad, rbh, m0, l0, O0, pb0);
        sm_chain(s1, j, qp * 32 + 16 + fr, quad, rbh, m1, l1, O1, pb1);
#pragma unroll
        for (int dt = 0; dt < 4; ++dt)
#pragma unroll
            for (int s2 = 0; s2 < 2; ++s2) {
                const LAS unsigned char* vp = L + A_VT + bufo + (32 * s2 + 4 * quad + (fr >> 2)) * A_VSTRIDE + (hl * 64 + 16 * dt + 4 * (fr & 3)) * 2;
                const v4i16_t lo = lds_tr16(vp), hi = lds_tr16(vp + 16 * A_VSTRIDE);
                const bf16x8 va = __builtin_shufflevector(lo, hi, 0, 1, 2, 3, 4, 5, 6, 7);
                O0[dt] = MFMA16(va, pb0[s2], O0[dt]); O1[dt] = MFMA16(va, pb1[s2], O1[dt]);
            }
        __syncthreads();
    }
#undef A_FETCH
#undef A_STAGE
    l0 = quads_sum(l0); l1 = quads_sum(l1);
    const float inv0 = 1.0f / l0, inv1 = 1.0f / l1;
    if (store)
#pragma unroll
    for (int dt = 0; dt < 4; ++dt) { u32x2 w; w.x = cvtpk(O0[dt][0] * inv0, O0[dt][1] * inv0); w.y = cvtpk(O0[dt][2] * inv0, O0[dt][3] * inv0);
        *(u32x2*)(QA + (size_t)qrow * 512 + h * 64 + 16 * dt + 4 * quad) = w;
        w.x = cvtpk(O1[dt][0] * inv1, O1[dt][1] * inv1); w.y = cvtpk(O1[dt][2] * inv1, O1[dt][3] * inv1);
        *(u32x2*)(QA + (size_t)(qrow + 16) * 512 + h * 64 + 16 * dt + 4 * quad) = w; }
}

constexpr int B_KS = 0, B_STRIDE = 144, B_VT = 18432, B_FLAGS = 36864, B_BUF = 9216;
__device__ __forceinline__ void attnB_unit(int b, int h, int qb, unsigned char* ws, LAS unsigned char* L, int store) {
    int tid = threadIdx.x; asm volatile("" : "+v"(tid));
    const int lane = tid & 63, wid = __builtin_amdgcn_readfirstlane(tid >> 6), fr = lane & 15, quad = lane >> 4;
    bf16_t* QB = (bf16_t*)(ws + WS_QB); const bf16_t* KB = (const bf16_t*)(ws + WS_KB); const bf16_t* VB = (const bf16_t*)(ws + WS_VB);
    const int q0 = qb * 128, qpos = q0 + wid * 16 + fr;
    const size_t qrow = (size_t)b * SEQ + qpos;
    const int srow = tid >> 3, sch = tid & 7;
    int kt = 2 * qb + 1;
    u32x4 kreg, vreg;
    { const size_t off = ((size_t)b * SEQ + kt * 64 + srow) * 512 + h * 64 + sch * 8; kreg = *(const u32x4*)(KB + off); vreg = *(const u32x4*)(VB + off); }
    bf16x8 qf[2];
    {
        const bf16_t* qp = QB + qrow * 512 + h * 64 + quad * 8;
        const u32x4 w0 = *(const u32x4*)qp, w1 = *(const u32x4*)(qp + 32);
        float f0[8], f1[8]; unpack8(w0, f0); unpack8(w1, f1);
#pragma unroll
        for (int e = 0; e < 8; ++e) { f0[e] *= 0.125f * 1.4426950408889634f; f1[e] *= 0.125f * 1.4426950408889634f; }
        qf[0] = __builtin_bit_cast(bf16x8, pack8(f0)); qf[1] = __builtin_bit_cast(bf16x8, pack8(f1));
    }
    LAS int* flags = (LAS int*)(L + B_FLAGS);
    if (tid < 160) flags[tid] = 0;
    float carry = 0.f; bool wave_done = false;
    f32x4 O[4];
#pragma unroll
    for (int d = 0; d < 4; ++d) O[d] = (f32x4){0.f, 0.f, 0.f, 0.f};
    const int wave_qmax = q0 + wid * 16 + 15;
#define B_FETCH(kk) do { const size_t off_ = ((size_t)b * SEQ + (kk) * 64 + srow) * 512 + h * 64 + sch * 8; kreg = *(const u32x4*)(KB + off_); vreg = *(const u32x4*)(VB + off_); } while (0)
#define B_STAGE(bufo_) do { *(LAS u32x4*)(L + B_KS + (bufo_) + srow * B_STRIDE + sch * 16) = kreg; *(LAS u32x4*)(L + B_VT + (bufo_) + srow * B_STRIDE + sch * 16) = vreg; } while (0)
    B_STAGE(0);
    if (kt > 0) B_FETCH(kt - 1);
    __syncthreads();
    for (int it = 0;; ++it) {
        const int bufo = (it & 1) * B_BUF;
        if (kt > 0) { B_STAGE(B_BUF - bufo); if (kt > 1) B_FETCH(kt - 2); }
        const int kbase = kt * 64;
        if (!wave_done && kbase < wave_qmax) {
            f32x4 z[4];
#pragma unroll
            for (int t = 0; t < 4; ++t) {
                f32x4 a = (f32x4){0.f, 0.f, 0.f, 0.f};
#pragma unroll
                for (int ks = 0; ks < 2; ++ks) { const bf16x8 kf = *(const LAS bf16x8*)(L + B_KS + bufo + (16 * t + fr) * B_STRIDE + ks * 64 + quad * 16); a = MFMA16(kf, qf[ks], a); }
                z[t] = a;
            }
            f32x4 lk[4];
            if (kbase + 64 <= q0 + wid * 16) {
#pragma unroll
                for (int t = 0; t < 4; ++t)
#pragma unroll
                    for (int e = 0; e < 4; ++e) {
                        const float zz = z[t][e];
                        lk[t][e] = -(fmaxf(zz, 0.f) + __builtin_amdgcn_logf(1.0f + __builtin_amdgcn_exp2f(-fabsf(zz))));
                    }
            } else {
#pragma unroll
                for (int t = 0; t < 4; ++t)
#pragma unroll
                    for (int e = 0; e < 4; ++e) {
                        const float zz = z[t][e]; const bool before = (kbase + 16 * t + 4 * quad + e) < qpos;
                        const float v = -(fmaxf(zz, 0.f) + __builtin_amdgcn_logf(1.0f + __builtin_amdgcn_exp2f(-fabsf(zz))));
                        lk[t][e] = before ? v : 0.f;
                        z[t][e] = before ? zz : -1e30f;
                    }
            }
            float run = carry;
            f32x4 w[4];
#pragma unroll
            for (int t = 3; t >= 0; --t) {
                const float s3 = lk[t][3], s2 = s3 + lk[t][2], s1 = s2 + lk[t][1], s0 = s1 + lk[t][0];
                const Pair2 r16 = row_pair16(s0); const float pair = r16.lo + r16.hi; const Pair2 r32 = half_pair32(pair); const float tot = r32.lo + r32.hi;
                const float ex = ((quad & 1) ? 0.f : r16.hi) + ((quad & 2) ? 0.f : r32.hi) + run;
                w[t][0] = __builtin_amdgcn_exp2f((z[t][0] + ex) + s0); w[t][1] = __builtin_amdgcn_exp2f((z[t][1] + ex) + s1); w[t][2] = __builtin_amdgcn_exp2f((z[t][2] + ex) + s2); w[t][3] = __builtin_amdgcn_exp2f((z[t][3] + ex) + s3);
                run += tot;
            }
            carry = run;
            bf16x8 pb[2];
#pragma unroll
            for (int s2 = 0; s2 < 2; ++s2) { u32x4 ww; ww.x = cvtpk(w[2 * s2][0], w[2 * s2][1]); ww.y = cvtpk(w[2 * s2][2], w[2 * s2][3]); ww.z = cvtpk(w[2 * s2 + 1][0], w[2 * s2 + 1][1]); ww.w = cvtpk(w[2 * s2 + 1][2], w[2 * s2 + 1][3]); pb[s2] = __builtin_bit_cast(bf16x8, ww); }
#pragma unroll
            for (int dt = 0; dt < 4; ++dt)
#pragma unroll
                for (int s2 = 0; s2 < 2; ++s2) {
                    const LAS unsigned char* vp = L + B_VT + bufo + (32 * s2 + 4 * quad + (fr >> 2)) * B_STRIDE + (16 * dt + 4 * (fr & 3)) * 2;
                    const v4i16_t lo = lds_tr16(vp), hi = lds_tr16(vp + 16 * B_STRIDE);
                    const bf16x8 va = __builtin_shufflevector(lo, hi, 0, 1, 2, 3, 4, 5, 6, 7);
                    O[dt] = MFMA16(va, pb[s2], O[dt]);
                }
#if EARLY_EXIT
            wave_done = __all(carry < -105.0f * 1.4426950408889634f) != 0;
#endif
        }
        if (!wave_done && lane == 0) flags[it] = 1;
        __syncthreads();
        const int cont = flags[it];
        if (kt == 0 || !cont) break;
        --kt;
    }
    if (store)
#pragma unroll
    for (int dt = 0; dt < 4; ++dt) { u32x2 w; w.x = cvtpk(O[dt][0], O[dt][1]); w.y = cvtpk(O[dt][2], O[dt][3]);
        *(u32x2*)(QB + qrow * 512 + h * 64 + 16 * dt + 4 * quad) = w; }
#undef B_FETCH
#undef B_STAGE
}


#define XB_TMO      128
#define XB_XCNT(j)  (256  + 64 * (j))
#define XB_XSUB(j)  (1280 + 64 * (j))
#define XB_XGEN(j)  (2304 + 64 * (j))
#define XB_TOP      3328
#define XB_TOPGEN   3392
#define XCD_BAR_WORDS 3456
#define XB_SPIN_CAP (1u << 18)
__device__ __forceinline__ unsigned xb_ld(unsigned* p)              { return __hip_atomic_load(p, __ATOMIC_RELAXED, __HIP_MEMORY_SCOPE_AGENT); }
__device__ __forceinline__ unsigned xb_add(unsigned* p, unsigned v) { return __hip_atomic_fetch_add(p, v, __ATOMIC_RELAXED, __HIP_MEMORY_SCOPE_AGENT); }
__device__ __forceinline__ unsigned xb_xcc_id() { return (unsigned)__builtin_amdgcn_s_getreg((3 << 11) | 20) & 0xFu; }
#define XB_SPIN(cond, bar) do { unsigned _sp = 0; while (cond) { __builtin_amdgcn_s_sleep(1); \
    if ((++_sp & 255u) == 0u) { if (xb_ld(&(bar)[XB_TMO])) break; if (_sp > XB_SPIN_CAP) { atomicAdd(&(bar)[XB_TMO], 1u); break; } } } } while (0)
struct XcdBarrier { unsigned* bar; unsigned x; volatile LAS unsigned* st; };
__device__ __forceinline__ XcdBarrier xcd_barrier_post(unsigned* bar, volatile LAS unsigned* st) {
    XcdBarrier b; b.bar = bar; b.x = xb_xcc_id(); b.st = st;
    if (threadIdx.x == 0) (void)xb_add(&bar[XB_XCNT(b.x)], 1u);
    return b;
}
__device__ __forceinline__ void xcd_barrier_complete(unsigned* bar, unsigned x, unsigned& nloc, unsigned& nx) {
    const unsigned G = gridDim.x * gridDim.y * gridDim.z;
    unsigned sum, cnt, mine, sp = 0u;
    for (;;) {
        sum = 0u; cnt = 0u; mine = 0u;
#pragma unroll
        for (unsigned j = 0; j < 16; ++j) { const unsigned c = xb_ld(&bar[XB_XCNT(j)]); sum += c; cnt += (c > 0u) ? 1u : 0u; mine = (j == x) ? c : mine; }
        if (sum == G) break;
        __builtin_amdgcn_s_sleep(1);
        if ((++sp & 255u) == 0u) { if (xb_ld(&bar[XB_TMO])) break; if (sp > XB_SPIN_CAP) { atomicAdd(&bar[XB_TMO], 1u); break; } }
    }
    nloc = mine > 0u ? mine : 1u; nx = cnt > 0u ? cnt : 1u;
}
__device__ __forceinline__ void xcd_barrier(const XcdBarrier& b) {
    asm volatile("s_waitcnt vmcnt(0)" ::: "memory");
    __syncthreads();
    if (threadIdx.x == 0) {
        unsigned* bar = b.bar;
        __builtin_amdgcn_s_waitcnt(0);
        unsigned nloc = b.st[0], nx = b.st[1];
        if (nloc == 0u) { xcd_barrier_complete(bar, b.x, nloc, nx); b.st[0] = nloc; b.st[1] = nx; }
        const unsigned old = xb_add(&bar[XB_XSUB(b.x)], 1u);
        const unsigned gen = old / nloc;
        if (old + 1u == (gen + 1u) * nloc) {
            __builtin_amdgcn_fence(__ATOMIC_RELEASE, "agent");
            asm volatile("s_waitcnt vmcnt(0)" ::: "memory");
            const unsigned og = xb_add(&bar[XB_TOP], 1u);
            const unsigned tg = og / nx;
            if (og + 1u == (tg + 1u) * nx) xb_add(&bar[XB_TOPGEN], 1u);
            else XB_SPIN(xb_ld(&bar[XB_TOPGEN]) == tg, bar);
            __builtin_amdgcn_fence(__ATOMIC_ACQUIRE, "agent");
            xb_add(&bar[XB_XGEN(b.x)], 1u);
            asm volatile("s_waitcnt vmcnt(0)" ::: "memory");
        } else {
            XB_SPIN(xb_ld(&bar[XB_XGEN(b.x)]) == gen, bar);
            __builtin_amdgcn_fence(__ATOMIC_ACQUIRE, "agent");
            asm volatile("s_waitcnt vmcnt(0)" ::: "memory");
        }
    }
    __syncthreads();
}

struct Args { const float* in[18]; float* out; unsigned char* ws; };

__global__ void __launch_bounds__(512, 2) fwd_megakernel(Args a) {
    extern __shared__ __attribute__((aligned(16))) unsigned char lds_raw[];
    LAS unsigned char* lds = (LAS unsigned char*)lds_raw;
    cg::grid_group grid = cg::this_grid();
    const int G = gridDim.x, bx = blockIdx.x;
    const int vcu = (G % 8 == 0) ? (bx % 8) * (G / 8) + bx / 8 : bx;
    const int NGW = G * 8, NGT = G * 512;
#define PHASE_IDS int tid = threadIdx.x; asm volatile("" : "+v"(tid)); const int lane = tid & 63, wave = __builtin_amdgcn_readfirstlane(tid >> 6), gw = vcu * 8 + wave, gt = vcu * 512 + tid; (void)lane; (void)gw; (void)gt;
    unsigned char* ws = a.ws;
    {
        if (threadIdx.x < 2) ((volatile LAS unsigned*)(lds + XB_LDS_OFF))[threadIdx.x] = 0u;
        __syncthreads();
    }
    const XcdBarrier xbar = xcd_barrier_post((unsigned*)(ws + WS_BAR), (volatile LAS unsigned*)(lds + XB_LDS_OFF));
    float* stat = (float*)(ws + WS_STAT);
    bf16_t* XB = (bf16_t*)(ws + WS_XB);

    {
    PHASE_IDS
    for (int rep = 0; rep < REP_MISC; ++rep) {
    convert_weight(a.in[2], DM, NIN, (bf16_t*)(ws + WS_WIN), a.in[1], 0, lds, wave, lane, gw, NGW);
    for (int m0 = gw; m0 < T; m0 += 8 * NGW) {
        f32x4 v[8][4]; float s[8];
#pragma unroll
        for (int r = 0; r < 8; ++r) { const int m = m0 + r * NGW; const f32x4* xr = (const f32x4*)(a.in[0] + (size_t)(m < T ? m : 0) * DM) + lane;
#pragma unroll
            for (int j = 0; j < 4; ++j) v[r][j] = xr[64 * j]; }
#pragma unroll
        for (int r = 0; r < 8; ++r) { float ss = 0.f;
#pragma unroll
            for (int j = 0; j < 4; ++j) ss += (v[r][j].x * v[r][j].x + v[r][j].y * v[r][j].y) + (v[r][j].z * v[r][j].z + v[r][j].w * v[r][j].w);
            s[r] = wave_sum(ss); }
#pragma unroll
        for (int r = 0; r < 8; ++r) { const int m = m0 + r * NGW; if (m < T) {
            u32x2* o8 = (u32x2*)(XB + (size_t)m * DM) + lane;
#pragma unroll
            for (int j = 0; j < 4; ++j) { u32x2 w; w.x = cvtpk(v[r][j].x, v[r][j].y); w.y = cvtpk(v[r][j].z, v[r][j].w); o8[64 * j] = w; }
            if (lane < 16) stat[(size_t)m * 16 + lane] = (lane == 0) ? s[r] : 0.f; } }
    }
    }
    }
    if (a.ws == nullptr) grid.sync();
    {
        int tid = threadIdx.x; asm volatile("" : "+v"(tid));
        if (tid < 64) {
            unsigned* bar = xbar.bar; unsigned sp = 0u, c, sum, cnt, mine;
            for (;;) {
                c = (tid < 16) ? xb_ld(&bar[XB_XCNT(tid)]) : 0u;
                sum = c;
#pragma unroll
                for (int o = 1; o < 16; o <<= 1) sum += (unsigned)__shfl_xor((int)sum, o);
                sum = (unsigned)__shfl((int)sum, 0);
                cnt = (unsigned)__builtin_popcountll(__ballot(c > 0u));
                mine = (unsigned)__shfl((int)c, (int)xbar.x);
                if (sum == (unsigned)G) break;
                __builtin_amdgcn_s_sleep(1);
                if ((++sp & 255u) == 0u) { if (xb_ld(&bar[XB_TMO])) break; if (sp > XB_SPIN_CAP) { if (tid == 0) atomicAdd(&bar[XB_TMO], 1u); break; } }
            }
            if (tid == 0) { xbar.st[0] = mine > 0u ? mine : 1u; xbar.st[1] = cnt > 0u ? cnt : 1u; }
        }
        __syncthreads();
    }
    GRID_SYNC();

    for (int l = 0; l < NL; ++l) {
        const float* xres = (l == 0) ? a.in[0] : a.out;
        {
            const bf16_t* xin16 = (l == 0) ? XB : (const bf16_t*)a.out;
            pg8::Gemm g; g.A0 = g.A1 = g.A2 = xin16; g.B0 = g.B1 = g.B2 = (const bf16_t*)(ws + WS_WIN); g.lda = DM; g.ldb = DM; g.K = DM;
            pg8::Order<T, NIN, 1, 1> S; S.init(G, bx);
            EpiProj E{ws, stat, a.in[3] + (size_t)l * 3072};
            for (int rep = 0; rep < REP_G1; ++rep) pg8::gemm_phase(lds, g, S, E);
        }
        GRID_SYNC();
        {
            PHASE_IDS
            for (int rep = 0; rep < REP_MISC; ++rep) {
            convert_weight(a.in[9] + (size_t)l * 512 * 1024, 512, 1024, (bf16_t*)(ws + WS_WA), nullptr, 0, lds, wave, lane, gw, NGW);
            convert_weight(a.in[10] + (size_t)l * 512 * 1024, 512, 1024, (bf16_t*)(ws + WS_WB), nullptr, 0, lds, wave, lane, gw, NGW);
            convert_weight(a.in[12] + (size_t)l * 1024 * 1024, 1024, 1024, (bf16_t*)(ws + WS_WOUT), nullptr, 0, lds, wave, lane, gw, NGW);
            convert_weight(a.in[14] + (size_t)l * DM * NUP, DM, NUP, (bf16_t*)(ws + WS_WUP), a.in[13] + (size_t)l * DM, 1, lds, wave, lane, gw, NGW);
            {
                const float* Wc = a.in[11] + (size_t)l * 512 * 1024; const float* wp = a.in[7] + (size_t)l * 4 * 128 * 128; const float* sc = a.in[8] + (size_t)l * 512;
                bf16_t* WcT = (bf16_t*)(ws + WS_WC);
                for (int wi = gw; wi < 2048; wi += NGW) {
                    const int n = (wi & 15) * 64 + lane, gc = wi >> 4, gidx = gc >> 5, c4 = gc & 31;
                    const float* wcp = Wc + (size_t)(gidx * 128) * 1024 + n; const float* scp = sc + gidx * 128; const float* wpp = wp + (size_t)(gidx * 128 + c4 * 4) * 128;
                    float acc4[4] = {0.f, 0.f, 0.f, 0.f};
                    for (int e0 = 0; e0 < 128; e0 += 64) {
                        float wcv[64];
#pragma unroll
                        for (int k = 0; k < 64; ++k) wcv[k] = wcp[(size_t)(e0 + k) * 1024];
#pragma unroll
                        for (int k = 0; k < 64; ++k) wcv[k] *= scp[e0 + k];
#pragma unroll
                        for (int jj = 0; jj < 4; ++jj)
#pragma unroll
                            for (int k = 0; k < 64; ++k) acc4[jj] += wpp[jj * 128 + e0 + k] * wcv[k];
                    }
                    u32x2 w; w.x = cvtpk(acc4[0], acc4[1]); w.y = cvtpk(acc4[2], acc4[3]);
                    *(u32x2*)(WcT + (size_t)n * 512 + gidx * 128 + c4 * 4) = w;
                }
            }
            }
            __syncthreads();
            for (int rep = 0; rep < REP_A; ++rep)
            for (int u = vcu; u < 512; u += G) {
                const int c = u & 127, hq = (u >> 7) & 1, b = u >> 8;
                attnA_unit(b, c, hq, ws, a.in[4] + l * 64, a.in[5] + l * 64, a.in[6] + (size_t)l * 8 * 192, lds, rep == REP_A - 1);
            }
            for (int rep = 0; rep < REP_B; ++rep)
            for (int u = vcu; u < 1024; u += G) {
                const int qb = u & 63, h = (u >> 6) & 7, b = u >> 9;
                attnB_unit(b, h, qb, ws, lds, rep == REP_B - 1);
            }
            {
                const bf16_t* UC = (const bf16_t*)(ws + WS_UC); bf16_t* OC = (bf16_t*)(ws + WS_OC);
                for (int rep = 0; rep < REP_MISC; ++rep)
                if (NGW == 2048) {
                for (int wi = gw; wi < T; wi += 2 * NGW) {
                    const int ta = (wi >> 2) * 4 + (lane >> 4), tb = ((wi + NGW) >> 2) * 4 + (lane >> 4), gidx = ((wi & 3) + (wi >> 12)) & 3, cofs = gidx * 128 + (lane & 15) * 8;
                    if (gidx == 0) pool_rows2<2>(UC, OC, ta, tb, cofs); else if (gidx == 1) pool_rows2<4>(UC, OC, ta, tb, cofs); else if (gidx == 2) pool_rows2<8>(UC, OC, ta, tb, cofs); else pool_rows2<16>(UC, OC, ta, tb, cofs);
                }
                } else
                for (int wi = gw; wi < T; wi += NGW) {
                    const int t = (wi >> 2) * 4 + (lane >> 4), gidx = ((wi & 3) + (wi >> 11)) & 3, cofs = gidx * 128 + (lane & 15) * 8;
                    if (gidx == 0) pool_rows<2>(UC, OC, t, cofs); else if (gidx == 1) pool_rows<4>(UC, OC, t, cofs); else if (gidx == 2) pool_rows<8>(UC, OC, t, cofs); else pool_rows<16>(UC, OC, t, cofs);
                }
            }
        }
        GRID_SYNC();
        {
            PHASE_IDS
            for (int rep = 0; rep < REP_MISC; ++rep) convert_weight(a.in[17] + (size_t)l * DFF * DM, DFF, DM, (bf16_t*)(ws + WS_WDN), nullptr, 0, lds, wave, lane, gw, NGW);
            __syncthreads();
            pg8::Gemm g; g.A0 = (const bf16_t*)(ws + WS_QA); g.A1 = (const bf16_t*)(ws + WS_QB); g.A2 = (const bf16_t*)(ws + WS_OC);
            g.B0 = (const bf16_t*)(ws + WS_WA); g.B1 = (const bf16_t*)(ws + WS_WB); g.B2 = (const bf16_t*)(ws + WS_WC); g.lda = 512; g.ldb = 512; g.K = 512;
            pg8::Order<T, DM, 3, 0> S; S.init(G, bx);
            EpiBranch E{(const bf16_t*)(ws + WS_GATES), (bf16_t*)(ws + WS_MERGED)};
            for (int rep = 0; rep < REP_G235; ++rep) pg8::gemm_phase(lds, g, S, E);
        }
        GRID_SYNC();
        {
            pg8::Gemm g; g.A0 = g.A1 = g.A2 = (const bf16_t*)(ws + WS_MERGED); g.B0 = g.B1 = g.B2 = (const bf16_t*)(ws + WS_WOUT); g.lda = DM; g.ldb = DM; g.K = DM;
            pg8::Order<T, DM, 1, 0> S; S.init(G, bx);
            for (int rep = 0; rep < REP_G235; ++rep) { EpiResid E{xres, a.out, (bf16_t*)(ws + WS_X1B), stat, 1, rep == REP_G235 - 1, (l == 0) ? nullptr : (const bf16_t*)a.out, 0};     pg8::gemm_phase(lds, g, S, E); }
        }
        GRID_SYNC();
        {
            pg8::Gemm g; g.A0 = g.A1 = g.A2 = (const bf16_t*)(ws + WS_X1B); g.B0 = g.B1 = g.B2 = (const bf16_t*)(ws + WS_WUP); g.lda = DM; g.ldb = DM; g.K = DM;
            pg8::Order<T, NUP, 1, 1> S; S.init(G, bx);
            EpiUp E{stat, a.in[15] + (size_t)l * 3 * NUP, a.in[16] + (size_t)l * NUP, (bf16_t*)(ws + WS_ACT), (float*)(ws + WS_EDGE)};
            for (int rep = 0; rep < REP_G4; ++rep) pg8::gemm_phase(lds, g, S, E);
            if (l + 1 < NL) {
                pg8::Unit ulast; const int nfull = (T / 256) * (NUP / 256) / G;
                const bool idle = !S.next(nfull, ulast);
                const int nidle = S.halft() ? G : G - ((T / 256) * (NUP / 256) - nfull * G);
                if (nidle == G || idle) {
                    PHASE_IDS
                    const int rank = (nidle == G) ? vcu : (bx - (G - nidle));
                    convert_weight(a.in[2] + (size_t)(l + 1) * DM * NIN, DM, NIN, (bf16_t*)(ws + WS_WIN), a.in[1] + (size_t)(l + 1) * DM, 0, lds, wave, lane, rank * 8 + wave, nidle * 8);
                }
            }
        }
        GRID_SYNC();
        {
            PHASE_IDS
            const float* edge = (const float*)(ws + WS_EDGE); const float* convw = a.in[15] + (size_t)l * 3 * NUP; const float* convb = a.in[16] + (size_t)l * NUP;
            bf16_t* act = (bf16_t*)(ws + WS_ACT);
            for (int rep = 0; rep < REP_MISC; ++rep) {
            for (int it = gt; it < 256 * 2 * 704; it += NGT) {
                const int j4 = it % 704, rb = it / 704, rr = rb & 1, blk = rb >> 1, j = j4 * 4;
                const bool first = (blk & 127) == 0;
                const int cg_ = 256 * (j >> 7) + 2 * (j & 127);
                f32x4 cvv[2];
                const int pb = first ? blk : blk - 1;
                f32x4 W0[2], W1[2], W2[2], CB[2], C0[2], P3[2], XX[2];
#pragma unroll
                for (int bj = 0; bj < 2; ++bj) {
                    const int ch = bj * DFF + j; const size_t ec = (size_t)cg_ + bj * 4;
                    W0[bj] = *(const f32x4*)(convw + ch); W1[bj] = *(const f32x4*)(convw + NUP + ch); W2[bj] = *(const f32x4*)(convw + 2 * NUP + ch); CB[bj] = *(const f32x4*)(convb + ch);
                    C0[bj] = *(const f32x4*)(edge + ((size_t)blk * 4 + 0) * NUP + ec);
                    P3[bj] = *(const f32x4*)(edge + ((size_t)pb * 4 + 3) * NUP + ec);
                    XX[bj] = *(const f32x4*)(edge + ((rr == 0) ? ((size_t)pb * 4 + 2) : ((size_t)blk * 4 + 1)) * NUP + ec);
                }
#pragma unroll
                for (int bj = 0; bj < 2; ++bj) {
                    const f32x4 zero = (f32x4){0.f, 0.f, 0.f, 0.f};
                    const f32x4 p3 = first ? zero : P3[bj];
                    f32x4 u0, u1, u2;
                    if (rr == 0) { u0 = C0[bj]; u1 = p3; u2 = first ? zero : XX[bj]; }
                    else { u0 = XX[bj]; u1 = C0[bj]; u2 = p3; }
                    cvv[bj] = CB[bj] + W2[bj] * u0 + W1[bj] * u1 + W0[bj] * u2;
                }
                f32x4 o;
#pragma unroll
                for (int e = 0; e < 4; ++e) { const float gt_ = cvv[0][e]; o[e] = gt_ * sigmoidf_(gt_) * cvv[1][e]; }
                u32x2 w; w.x = cvtpk(o[0], o[1]); w.y = cvtpk(o[2], o[3]);
                *(u32x2*)(act + (size_t)(blk * 64 + rr) * DFF + j) = w;
            }
            }
        }
        GRID_SYNC();
        {
            pg8::Gemm g; g.A0 = g.A1 = g.A2 = (const bf16_t*)(ws + WS_ACT); g.B0 = g.B1 = g.B2 = (const bf16_t*)(ws + WS_WDN); g.lda = DFF; g.ldb = DFF; g.K = DFF;
            pg8::Order<T, DM, 1, 0> S; S.init(G, bx);
            for (int rep = 0; rep < REP_G235; ++rep) { EpiResid E{a.out, a.out, (bf16_t*)a.out, stat, (l + 1 < NL) ? 1 : 0, rep == REP_G235 - 1, (const bf16_t*)(ws + WS_X1B), (l + 1 < NL) ? 0 : 1};     pg8::gemm_phase(lds, g, S, E); }
        }
        if (l + 1 < NL) GRID_SYNC();
    }
}

extern "C" void kernel_launch(void* const* d_in, const int* in_sizes, int n_in, void* d_out, int out_size, void* d_ws, size_t ws_size, hipStream_t stream) {
    static int grid = 0;
    if (grid == 0) {
        int dev = 0, cus = 0, per_cu = 0;
        hipGetDevice(&dev);
        hipDeviceGetAttribute(&cus, hipDeviceAttributeMultiprocessorCount, dev);
        hipFuncSetAttribute((const void*)fwd_megakernel, hipFuncAttributeMaxDynamicSharedMemorySize, LDS_BYTES);
        hipOccupancyMaxActiveBlocksPerMultiprocessor(&per_cu, (const void*)fwd_megakernel, 512, LDS_BYTES);
        if (per_cu < 1) { fprintf(stderr, "kernel_launch: occupancy query says %d blocks per CU\n", per_cu); per_cu = 1; }
        (void)hipGetLastError();
        grid = cus * 1;
        if (n_in != 18 || ws_size < 256 * MiB) fprintf(stderr, "kernel_launch: unexpected n_in %d / ws_size %zu\n", n_in, ws_size);
    }
    if (hipMemsetAsync(d_ws, 0, WS_CTL_BYTES, stream) != hipSuccess) { fprintf(stderr, "kernel_launch: memset of the barrier words failed\n"); return; }
    Args a{};
    for (int i = 0; i < 18; ++i) a.in[i] = (const float*)d_in[i];
    a.out = (float*)d_out; a.ws = (unsigned char*)d_ws;
    void* args[] = {&a};
    hipError_t e = hipLaunchCooperativeKernel((const void*)fwd_megakernel, dim3(grid), dim3(512), args, LDS_BYTES, stream);
    if (e != hipSuccess) fprintf(stderr, "cooperative launch failed: %s (grid %d)\n", hipGetErrorString(e), grid);
}
```
